# Optimizing an MI355X kernel written in HIP

```python
import jax, jax.numpy as jnp
from jax import lax
import numpy as np

D_MODEL = 2048
BATCH = 4
SEQ = 4096
DEPTH = 4
DEC_BATCH = 16
DEC_SEQ = 64
PAST_LEN = 1024

CHUNK = 64
N_A_LAYERS = DEPTH // 2
N_B_LAYERS = DEPTH - N_A_LAYERS
GLA_HEADS = 4
GLA_DK = D_MODEL // 2 // GLA_HEADS
GLA_DV = D_MODEL // GLA_HEADS
GLA_RANK = 16
GLA_TAU = 16.0
GLA_QK = GLA_HEADS * GLA_DK
GLA_VR = GLA_HEADS * GLA_DV
GLA_IN = 2 * GLA_QK + 2 * GLA_VR + GLA_RANK
ATT_HEADS = 16
ATT_KV_HEADS = 4
ATT_DH = D_MODEL // ATT_HEADS
ATT_GROUP = ATT_HEADS // ATT_KV_HEADS
LEFT_CHUNKS = 8
ATT_WINDOW = LEFT_CHUNKS * CHUNK
ATT_BAND = ATT_WINDOW + CHUNK
MAX_REL = 256
N_REL = 2 * MAX_REL + 1
D_FF = 5632
CONV_W = 3
EPS = 1e-6

kernel_name = "yoco_gla_chunked_relbias_convffn_step"


def _rms_norm(x, g):
    xf = x.astype(jnp.float32)
    y = xf * lax.rsqrt(jnp.mean(xf * xf, axis=-1, keepdims=True) + EPS)
    return (y * g.astype(jnp.float32)).astype(x.dtype)


def _gla_scan(q, k, v, gk, s0):
    B, T, H, DK = q.shape
    DV = v.shape[-1]
    n = -(-T // CHUNK)
    pad = n * CHUNK - T

    def blocks(a):
        a = jnp.pad(a.astype(jnp.float32), ((0, 0), (0, pad), (0, 0), (0, 0)))
        return jnp.moveaxis(a.reshape(B, n, CHUNK, H, a.shape[-1]), 1, 0)

    tri = jnp.tril(jnp.ones((CHUNK, CHUNK), bool))[None, :, :, None, None]

    def step(S, blk):
        qc, kc, vc, gc = blk
        b = jnp.cumsum(gc, axis=1)
        decay = jnp.exp(jnp.where(tri, b[:, :, None] - b[:, None, :], -jnp.inf))
        att = jnp.einsum('bthk,bshk,btshk->bhts', qc, kc, decay)
        o = (jnp.einsum('bhts,bshv->bthv', att, vc)
             + jnp.einsum('bthk,bhkv->bthv', qc * jnp.exp(b), S))
        b_end = b[:, -1]
        S = (jnp.exp(b_end)[..., None] * S
             + jnp.einsum('bshk,bshv->bhkv', kc * jnp.exp(b_end[:, None] - b), vc))
        return S, o

    S, o = lax.scan(step, s0.astype(jnp.float32), (blocks(q), blocks(k), blocks(v), blocks(gk)))
    o = jnp.moveaxis(o, 0, 1).reshape(B, n * CHUNK, H, DV)[:, :T]
    return o.astype(v.dtype), S.astype(s0.dtype)


def _gla_mixer(h, s0, w_in, w_gate, b_gate, head_norm, w_o):
    B, T, _ = h.shape
    proj = h @ w_in
    q, k, v, r, g_low = jnp.split(
        proj, [GLA_QK, 2 * GLA_QK, 2 * GLA_QK + GLA_VR, 2 * GLA_QK + 2 * GLA_VR], axis=-1)
    q = q.reshape(B, T, GLA_HEADS, GLA_DK) * (GLA_DK ** -0.5)
    k = k.reshape(B, T, GLA_HEADS, GLA_DK)
    v = v.reshape(B, T, GLA_HEADS, GLA_DV)
    gk = jax.nn.log_sigmoid((g_low @ w_gate + b_gate).astype(jnp.float32)) / GLA_TAU
    gk = gk.reshape(B, T, GLA_HEADS, GLA_DK)
    o, s_new = _gla_scan(q, k, v, gk, s0)
    o = _rms_norm(o, head_norm).reshape(B, T, GLA_VR) * jax.nn.silu(r)
    return o @ w_o, s_new


def _attend(q, k, v, q_pos, k_pos, k_valid, rel_bias):
    B, Tq = q.shape[:2]
    Tk = k.shape[1]
    qg = q.reshape(B, Tq, ATT_KV_HEADS, ATT_GROUP, ATT_DH)
    s = jnp.einsum('bqngd,bknd->bngqk', qg, k).astype(jnp.float32) * (ATT_DH ** -0.5)
    rel = jnp.clip(q_pos[:, None] - k_pos[None, :], -MAX_REL, MAX_REL) + MAX_REL
    bias = rel_bias[:, rel].astype(jnp.float32).reshape(ATT_KV_HEADS, ATT_GROUP, Tq, Tk)
    s = jnp.where(k_valid[None, None, None, None, :], s + bias[None], -jnp.inf)
    p = jax.nn.softmax(s, axis=-1)
    o = jnp.einsum('bngqk,bknd->bqngd', p.astype(v.dtype), v)
    return o.reshape(B, Tq, ATT_HEADS, ATT_DH)


def _band_attention_prompt(q, k, v, rel_bias):
    B, S = q.shape[:2]
    n = S // CHUNK
    kp = jnp.pad(k, ((0, 0), (ATT_WINDOW, 0), (0, 0), (0, 0)))
    vp = jnp.pad(v, ((0, 0), (ATT_WINDOW, 0), (0, 0), (0, 0)))
    qb = jnp.moveaxis(q.reshape(B, n, CHUNK, ATT_HEADS, ATT_DH), 1, 0)

    def one(args):
        c, qc = args
        start = c * CHUNK
        kb = lax.dynamic_slice_in_dim(kp, start, ATT_BAND, axis=1)
        vb = lax.dynamic_slice_in_dim(vp, start, ATT_BAND, axis=1)
        q_pos = start + jnp.arange(CHUNK)
        k_pos = start - ATT_WINDOW + jnp.arange(ATT_BAND)
        return _attend(qc, kb, vb, q_pos, k_pos, k_pos >= 0, rel_bias)

    o = lax.map(one, (jnp.arange(n), qb))
    return jnp.moveaxis(o, 0, 1).reshape(B, S, ATT_HEADS, ATT_DH)


def _band_attention_step(q, k_new, v_new, k_cache, v_cache, rel_bias):
    T = q.shape[1]
    W = k_cache.shape[1]
    k = jnp.concatenate([k_cache.astype(k_new.dtype), k_new], axis=1)
    v = jnp.concatenate([v_cache.astype(v_new.dtype), v_new], axis=1)
    q_pos = PAST_LEN + jnp.arange(T)
    k_pos = jnp.concatenate([PAST_LEN - W + jnp.arange(W), PAST_LEN + jnp.arange(T)])
    return _attend(q, k, v, q_pos, k_pos, k_pos >= 0, rel_bias)


def _conv_ffn(h, prev, w_up, conv_w, conv_b, w_down):
    T = h.shape[1]
    gate, val = jnp.split(h @ w_up, 2, axis=-1)
    ext = jnp.concatenate([prev.astype(gate.dtype), gate], axis=1)
    conv = conv_b
    for j in range(CONV_W):
        conv = conv + conv_w[j] * ext[:, j:j + T]
    return (jax.nn.silu(conv) * val) @ w_down, ext[:, T:]


def _trunk(x, gla_s0, conv_s0, k_cache, v_cache, norm_gains, gla_w_in, gla_w_gate,
           gla_b_gate, gla_head_norm, gla_w_o, kv_norm, att_w_kv, att_w_q, att_rel_bias,
           att_w_o, ffn_w_up, ffn_conv_w, ffn_conv_b, ffn_w_down):
    prompt = k_cache is None
    B, T, _ = x.shape
    gla_new, conv_new = [], []
    k_sh = v_sh = None
    for l in range(DEPTH):
        g = norm_gains[l]
        if l == N_A_LAYERS:
            kv = _rms_norm(x, kv_norm) @ att_w_kv
            k_sh, v_sh = jnp.split(kv, 2, axis=-1)
            k_sh = k_sh.reshape(B, T, ATT_KV_HEADS, ATT_DH)
            v_sh = v_sh.reshape(B, T, ATT_KV_HEADS, ATT_DH)
        h = _rms_norm(x, g[0])
        if l < N_A_LAYERS:
            m, s = _gla_mixer(h, gla_s0[l], gla_w_in[l], gla_w_gate[l], gla_b_gate[l],
                              gla_head_norm[l], gla_w_o[l])
            gla_new.append(s)
        else:
            j = l - N_A_LAYERS
            q = (h @ att_w_q[j]).reshape(B, T, ATT_HEADS, ATT_DH)
            if prompt:
                o = _band_attention_prompt(q, k_sh, v_sh, att_rel_bias[j])
            else:
                o = _band_attention_step(q, k_sh, v_sh, k_cache, v_cache, att_rel_bias[j])
            m = o.reshape(B, T, ATT_HEADS * ATT_DH) @ att_w_o[j]
        x = x + _rms_norm(m, g[1])
        f, c = _conv_ffn(_rms_norm(x, g[2]), conv_s0[l], ffn_w_up[l], ffn_conv_w[l],
                         ffn_conv_b[l], ffn_w_down[l])
        conv_new.append(c)
        x = x + _rms_norm(f, g[3])
    if prompt:
        keep = min(ATT_WINDOW, T)
        k_rows, v_rows = k_sh[:, T - keep:], v_sh[:, T - keep:]
    else:
        k_rows, v_rows = k_sh, v_sh
    return x, jnp.stack(gla_new), jnp.stack(conv_new), k_rows, v_rows


def setup_inputs(seed: int = 0) -> dict:
    key = jax.random.key(seed)
    ks = jax.random.split(key, 24)
    f32 = jnp.float32

    def nrm(k, shape, scale):
        return jax.random.normal(k, shape, f32) * scale

    kv_win = min(ATT_WINDOW, PAST_LEN)
    return {
        "x_prompt": nrm(ks[0], (BATCH, SEQ, D_MODEL), 1.0),
        "x_sample": nrm(ks[1], (DEC_BATCH, DEC_SEQ, D_MODEL), 1.0),
        "state_gla": nrm(ks[2], (N_A_LAYERS, DEC_BATCH, GLA_HEADS, GLA_DK, GLA_DV), 1.0),
        "state_ffn_conv": nrm(ks[3], (DEPTH, DEC_BATCH, CONV_W - 1, D_FF), 1.0),
        "cache_k": nrm(ks[4], (DEC_BATCH, kv_win, ATT_KV_HEADS, ATT_DH), 1.0),
        "cache_v": nrm(ks[5], (DEC_BATCH, kv_win, ATT_KV_HEADS, ATT_DH), 1.0),
        "norm_gains": 1.0 + nrm(ks[6], (DEPTH, 4, D_MODEL), 0.05),
        "gla_w_in": nrm(ks[7], (N_A_LAYERS, D_MODEL, GLA_IN), D_MODEL ** -0.5),
        "gla_w_gate": nrm(ks[8], (N_A_LAYERS, GLA_RANK, GLA_QK), GLA_RANK ** -0.5),
        "gla_b_gate": nrm(ks[9], (N_A_LAYERS, GLA_QK), 0.1),
        "gla_head_norm": 1.0 + nrm(ks[10], (N_A_LAYERS, GLA_DV), 0.05),
        "gla_w_o": nrm(ks[11], (N_A_LAYERS, GLA_VR, D_MODEL), GLA_VR ** -0.5),
        "kv_norm": 1.0 + nrm(ks[12], (D_MODEL,), 0.05),
        "att_w_kv": nrm(ks[13], (D_MODEL, 2 * ATT_KV_HEADS * ATT_DH), D_MODEL ** -0.5),
        "att_w_q": nrm(ks[14], (N_B_LAYERS, D_MODEL, ATT_HEADS * ATT_DH), D_MODEL ** -0.5),
        "att_rel_bias": nrm(ks[15], (N_B_LAYERS, ATT_HEADS, N_REL), 0.1),
        "att_w_o": nrm(ks[16], (N_B_LAYERS, ATT_HEADS * ATT_DH, D_MODEL), (ATT_HEADS * ATT_DH) ** -0.5),
        "ffn_w_up": nrm(ks[17], (DEPTH, D_MODEL, 2 * D_FF), D_MODEL ** -0.5),
        "ffn_conv_w": nrm(ks[18], (DEPTH, CONV_W, D_FF), CONV_W ** -0.5),
        "ffn_conv_b": nrm(ks[19], (DEPTH, D_FF), 0.02),
        "ffn_w_down": nrm(ks[20], (DEPTH, D_FF, D_MODEL), D_FF ** -0.5),
    }


def reference(x_prompt, x_sample, state_gla, state_ffn_conv, cache_k, cache_v, norm_gains,
              gla_w_in, gla_w_gate, gla_b_gate, gla_head_norm, gla_w_o, kv_norm, att_w_kv,
              att_w_q, att_rel_bias, att_w_o, ffn_w_up, ffn_conv_w, ffn_conv_b, ffn_w_down):
    B = x_prompt.shape[0]
    gla_zero = jnp.zeros((N_A_LAYERS, B, GLA_HEADS, GLA_DK, GLA_DV), x_prompt.dtype)
    conv_zero = jnp.zeros((DEPTH, B, CONV_W - 1, D_FF), x_prompt.dtype)
    y_prompt, gla_p, conv_p, k_p, v_p = _trunk(
        x_prompt, gla_zero, conv_zero, None, None, norm_gains, gla_w_in, gla_w_gate,
        gla_b_gate, gla_head_norm, gla_w_o, kv_norm, att_w_kv, att_w_q, att_rel_bias,
        att_w_o, ffn_w_up, ffn_conv_w, ffn_conv_b, ffn_w_down)
    y_sample, gla_s, conv_s, k_s, v_s = _trunk(
        x_sample, state_gla, state_ffn_conv, cache_k, cache_v, norm_gains, gla_w_in,
        gla_w_gate, gla_b_gate, gla_head_norm, gla_w_o, kv_norm, att_w_kv, att_w_q,
        att_rel_bias, att_w_o, ffn_w_up, ffn_conv_w, ffn_conv_b, ffn_w_down)
    return (y_prompt, y_sample, gla_p, gla_s, conv_p, conv_s, k_p, v_p, k_s, v_s)
```

```cpp
#include <hip/hip_runtime.h>
#include <hip/hip_cooperative_groups.h>
#include <cstdio>
#include <cstdint>
#define LAS __attribute__((address_space(3)))
__device__ __forceinline__ int opq_tid() { int t = threadIdx.x; asm volatile("" : "+v"(t)); return t; }
namespace pg8 {
#define PG8_LAS __attribute__((address_space(3)))
typedef unsigned short bf16_t;
typedef short bf16x8 __attribute__((ext_vector_type(8)));
typedef float f32x4 __attribute__((ext_vector_type(4)));
typedef unsigned u32x4 __attribute__((ext_vector_type(4)));
constexpr int BM = 256, BK = 64, HALF = 128, HTB = HALF * BK * 2  , STAGE_BYTES = 8 * HTB, NXCD = 8, WGM = 8;

__host__ __device__ __forceinline__ int lds_byte(int r, int c) { const int st = (r >> 4) * 2 + (c >> 5), rr = r & 15, cc = c & 31, ob = rr * 64 + cc * 2; return st * 1024 + (ob ^ (((ob >> 9) & 1) << 5)); }
__host__ __device__ __forceinline__ void stage_rc(int b, int& R, int& C) { const int st = b / 1024, sb = b % 1024, swz = sb ^ (((sb >> 9) & 1) << 5); R = (st >> 1) * 16 + swz / 64; C = (st & 1) * 32 + (swz % 64) / 2; }
__host__ __device__ __forceinline__ int perm32(int rho) { const int n = rho >> 4, i = rho & 15; return 8 * (i >> 2) + 4 * n + (i & 3); }

struct Unit { int pm, pn, ks, nt; };
struct Gemm { const bf16_t* A; const bf16_t* Bt; int M, N, K; };

struct StaticOrder {
    int nM, nN, nwg, G, c;
    __host__ __device__ void init(int M, int N, int G_, int c_) { nM = M / BM; nN = N / BM; nwg = nM * nN; G = G_; c = c_; }
    __host__ __device__ bool next(int i, Unit& u) const {
        const long L = (long)i * G + c; if (L >= nwg) return false;
        int wgid = (int)L; { const int q = nwg / NXCD, r = nwg % NXCD, xcd = wgid % NXCD, off = wgid / NXCD; wgid = (xcd < r ? xcd * (q + 1) : r * (q + 1) + (xcd - r) * q) + off; }
        const int nig = WGM * nN, gid = wgid / nig, fm = gid * WGM, gsz = (nM - fm) < WGM ? (nM - fm) : WGM;
        u.pm = fm + ((wgid % nig) % gsz); u.pn = (wgid % nig) / gsz; u.ks = 0; u.nt = 0; return true;
    }
    __device__ __forceinline__ void a_ready(const Unit&) const {}
    __device__ __forceinline__ void done(const Unit&) const {}
};
struct TailSplitOrder {
    int nMf, nMt, nN, nfull, S, ntk, G, c;
    __host__ __device__ void init(int nMf_, int nMt_, int N, int S_, int K, int G_, int c_) { nMf = nMf_; nMt = nMt_; nN = N / BM; nfull = nMf * nN; S = S_; ntk = K / BK / S_; G = G_; c = c_; }
    __host__ __device__ bool next(int i, Unit& u) const {
        const long L = (long)i * G + c;
        const bool full = L < nfull;
        const int r = (int)(L - nfull);
        if (!full && r >= nMt * nN * S) return false;
        int wgid = full ? (int)L : 0; { const int q = nfull / NXCD, rr = nfull % NXCD, xcd = wgid % NXCD, off = wgid / NXCD; wgid = (xcd < rr ? xcd * (q + 1) : rr * (q + 1) + (xcd - rr) * q) + off; }
        const int nig = WGM * nN, gid = wgid / nig, fm = gid * WGM, gsz = (nMf - fm) < WGM ? (nMf - fm) : WGM;
        const int fpm = fm + ((wgid % nig) % gsz), fpn = (wgid % nig) / gsz;
        const int rc = full ? 0 : r, tile = rc / S;
        const int pm_ = full ? fpm : nMf + tile % nMt, pn_ = full ? fpn : tile / nMt, ks_ = full ? 0 : rc % S, nt_ = full ? 0 : ntk;
        u.pm = pm_; u.pn = pn_; u.ks = ks_; u.nt = nt_; return true;
    }
    __device__ __forceinline__ void a_ready(const Unit&) const {}
    __device__ __forceinline__ void done(const Unit&) const {}
};
typedef unsigned u32x2v __attribute__((ext_vector_type(2)));
typedef float f32x2c_t __attribute__((ext_vector_type(2))); typedef __bf16 bf16x2c_t __attribute__((ext_vector_type(2)));
__device__ __forceinline__ unsigned cvt_pk_bf16(float lo, float hi) { f32x2c_t v = {lo, hi}; bf16x2c_t b = __builtin_convertvector(v, bf16x2c_t); return __builtin_bit_cast(unsigned, b); }

struct EpiGen {
    static constexpr bool PERM = true, AFTER_DRAIN = false;
    bf16_t* O; int ldc; int kvq; bf16_t* KVP; bf16_t* KVS; float* okp; float* ovp; float* oks; float* ovs; const float* rs;
    __device__ __forceinline__ void operator()(const f32x4 (&acc)[2][2][4][2], const Unit& u, int wr, int wc, int fr, int fq) const {
        const int row0 = u.pm * BM + wr * 64 + fr;
        if (!kvq || u.pn >= 4) {
            const int col0 = u.pn * BM - (kvq ? 1024 : 0) + wc * 32 + 8 * fq;
#pragma unroll
            for (int ai = 0; ai < 2; ++ai)
#pragma unroll
                for (int m = 0; m < 4; ++m) { bf16_t* rowp = O + (size_t)(row0 + ai * HALF + m * 16) * ldc + col0; const float rr = rs[row0 + ai * HALF + m * 16];
#pragma unroll
                    for (int bj = 0; bj < 2; ++bj) { const f32x4 v0 = acc[ai][bj][m][0] * rr, v1 = acc[ai][bj][m][1] * rr;
                        u32x4 w; w.x = cvt_pk_bf16(v0[0], v0[1]); w.y = cvt_pk_bf16(v0[2], v0[3]); w.z = cvt_pk_bf16(v1[0], v1[1]); w.w = cvt_pk_bf16(v1[2], v1[3]);
                        *(u32x4*)(rowp + bj * HALF) = w; } }
        } else {
            const int col0 = u.pn * BM + wc * 32 + 8 * fq;
            const bool isv = col0 >= 512; const int oc = isv ? col0 - 512 : col0;
#pragma unroll
            for (int ai = 0; ai < 2; ++ai)
#pragma unroll
                for (int m = 0; m < 4; ++m) {
                    const int r = row0 + ai * HALF + m * 16; const float rr = rs[r];
                    bf16_t* rowp; float* fo = nullptr;
                    if (r < 16384) { rowp = KVP + (size_t)r * 1024 + col0; const int t = r & 4095;
                        if (t >= 3584) fo = (isv ? ovp : okp) + ((size_t)(r >> 12) * 512 + (t - 3584)) * 512 + oc; }
                    else { const int rs = r - 16384, b = rs >> 6, t = rs & 63; rowp = KVS + ((size_t)b * 576 + 512 + t) * 1024 + col0; fo = (isv ? ovs : oks) + (size_t)rs * 512 + oc; }
#pragma unroll
                    for (int bj = 0; bj < 2; ++bj) { const f32x4 v0 = acc[ai][bj][m][0] * rr, v1 = acc[ai][bj][m][1] * rr;
                        u32x4 w; w.x = cvt_pk_bf16(v0[0], v0[1]); w.y = cvt_pk_bf16(v0[2], v0[3]); w.z = cvt_pk_bf16(v1[0], v1[1]); w.w = cvt_pk_bf16(v1[2], v1[3]);
                        *(u32x4*)(rowp + bj * HALF) = w;
                        if (fo) { *(f32x4*)(fo + bj * HALF) = v0; *(f32x4*)(fo + bj * HALF + 4) = v1; } } }
        }
    }
};
struct EpiF32 {
    static constexpr bool PERM = false, AFTER_DRAIN = false;
    bf16_t* O; int ldc; float* P; int prow0; size_t pstride;
    __device__ __forceinline__ void operator()(const f32x4 (&acc)[2][2][4][2], const Unit& u, int wr, int wc, int fr, int fq) const {
        const int row0 = u.pm * BM + wr * 64 + fr, col0 = u.pn * BM + wc * 32 + 4 * fq;
        if (u.nt) {
            float* base = P + (size_t)u.ks * pstride - (size_t)prow0 * ldc;
#pragma unroll
            for (int ai = 0; ai < 2; ++ai)
#pragma unroll
                for (int m = 0; m < 4; ++m) { float* rowp = base + (size_t)(row0 + ai * HALF + m * 16) * ldc + col0;
#pragma unroll
                    for (int bj = 0; bj < 2; ++bj)
#pragma unroll
                        for (int n = 0; n < 2; ++n) *(f32x4*)(rowp + bj * HALF + n * 16) = acc[ai][bj][m][n]; }
        } else {
#pragma unroll
            for (int ai = 0; ai < 2; ++ai)
#pragma unroll
                for (int m = 0; m < 4; ++m) { bf16_t* rowp = O + (size_t)(row0 + ai * HALF + m * 16) * ldc + col0;
#pragma unroll
                    for (int bj = 0; bj < 2; ++bj)
#pragma unroll
                        for (int n = 0; n < 2; ++n) { const f32x4 v = acc[ai][bj][m][n]; u32x2v w; w.x = cvt_pk_bf16(v[0], v[1]); w.y = cvt_pk_bf16(v[2], v[3]); *(u32x2v*)(rowp + bj * HALF + n * 16) = w; } }
        }
    }
};

struct EpiUp {
    static constexpr bool PERM = true, AFTER_DRAIN = false;
    bf16_t* HF; const float* cw; const float* cb; float* GT; float* GH; float* VH; const float* rs;
    __device__ __forceinline__ void operator()(const f32x4 (&acc)[2][2][4][2], const Unit& u, int wr, int wc, int fr, int fq) const {
        const int lane = fr | (fq << 4);
        const int src1 = (lane & 48) | ((fr + 15) & 15), src2 = (lane & 48) | ((fr + 14) & 15);
        const int jb = 128 * u.pn + 32 * wc + 8 * fq;
#pragma unroll
        for (int n = 0; n < 2; ++n) {
            const int j0 = jb + 4 * n;
            const f32x4 w0 = *(const f32x4*)(cw + j0), w1 = *(const f32x4*)(cw + 5632 + j0), w2 = *(const f32x4*)(cw + 2 * 5632 + j0), bb = *(const f32x4*)(cb + j0);
#pragma unroll
            for (int ai = 0; ai < 2; ++ai) {
                f32x4 p1 = (f32x4){0.f, 0.f, 0.f, 0.f}, p2 = p1;
#pragma unroll
                for (int m = 0; m < 4; ++m) {
                    const float rr = rs[u.pm * BM + ai * HALF + wr * 64 + m * 16 + fr];
                    const f32x4 G = acc[ai][0][m][n] * rr, V = acc[ai][1][m][n] * rr;
                    f32x4 r1, r2;
#pragma unroll
                    for (int e = 0; e < 4; ++e) { r1[e] = __shfl(G[e], src1); r2[e] = __shfl(G[e], src2); }
                    const f32x4 g1 = fr >= 1 ? r1 : p1, g2 = fr >= 2 ? r2 : p2;
                    const f32x4 c = bb + w0 * g2 + w1 * g1 + w2 * G;
                    f32x4 h;
#pragma unroll
                    for (int e = 0; e < 4; ++e) h[e] = c[e] * __builtin_amdgcn_rcpf(1.f + __expf(-c[e])) * V[e];
                    const int row = u.pm * BM + ai * HALF + wr * 64 + m * 16 + fr;
                    if (m == 0 && fr < 2) { const size_t o = ((size_t)(row >> 6) * 2 + fr) * 5632 + j0; *(f32x4*)(GH + o) = G; *(f32x4*)(VH + o) = V; }
                    else { u32x2v w; w.x = cvt_pk_bf16(h[0], h[1]); w.y = cvt_pk_bf16(h[2], h[3]); *(u32x2v*)(HF + (size_t)row * 5632 + j0) = w; }
                    if (m == 3 && fr >= 14) { const size_t o = ((size_t)(row >> 6) * 2 + (fr - 14)) * 5632 + j0; *(f32x4*)(GT + o) = G; }
                    p1 = r1; p2 = r2;
                }
            }
        }
    }
};
template <class Epi, class Sched, bool ALIGN_EPI = false, bool SP2 = false>
__device__ __forceinline__ void gemm_phase(PG8_LAS unsigned char* lds, const Gemm g, const Sched& S, const Epi& E) {
    const int tid = opq_tid(), wid = __builtin_amdgcn_readfirstlane(tid >> 6), lane = tid & 63, wr = wid >> 2, wc = wid & 3, fr = lane & 15, fq = lane >> 4;
    const int K = g.K, nt = K / BK;
    unsigned voffA[2], voffB[2];
#pragma unroll
    for (int i = 0; i < 2; ++i) { int R, C; stage_rc(tid * 16 + i * 8192, R, C); const int Rb = Epi::PERM ? ((R & ~31) + perm32(R & 31)) : R;
        voffA[i] = (unsigned)(R * K + C) * 2u; voffB[i] = (unsigned)(Rb * K + C) * 2u; }
    const size_t kstep = (size_t)(BK * 2);
    const size_t hstep = (size_t)HALF * K * 2;
    const size_t tstep = 2 * hstep;
    const unsigned ldsw = (unsigned)wid * 1024u;
    const int aoff = lds_byte(wr * 64 + fr, fq * 8), boff = lds_byte(wc * 32 + fr, fq * 8);
#define PG8_SA(b, h) (((b) * 2 + (h)) * HTB)
#define PG8_SB(b, h) ((4 + (b) * 2 + (h)) * HTB)
#define PG8_STAGE(bufoff, gbase, voff) do { _Pragma("unroll") for (int _i = 0; _i < 2; ++_i) \
        __builtin_amdgcn_global_load_lds((const unsigned*)((const char*)(gbase) + (voff)[_i]), (PG8_LAS unsigned*)(lds + (bufoff) + ldsw + _i * 8192), 16, 0, 0); } while (0)
#define PG8_LDA(dst, b, h) do { _Pragma("unroll") for (int m = 0; m < 4; ++m) _Pragma("unroll") for (int k = 0; k < 2; ++k) dst[m][k] = *(const PG8_LAS bf16x8*)(lds + PG8_SA(b, h) + aoff + m * 2048 + k * 1024); } while (0)
#define PG8_LDB(dst, b, h) do { _Pragma("unroll") for (int n = 0; n < 2; ++n) _Pragma("unroll") for (int k = 0; k < 2; ++k) dst[n][k] = *(const PG8_LAS bf16x8*)(lds + PG8_SB(b, h) + boff + n * 2048 + k * 1024); } while (0)
#define PG8_MMA(ai, bj, At, Bt) do { __builtin_amdgcn_s_setprio(1); _Pragma("unroll") for (int m = 0; m < 4; ++m) _Pragma("unroll") for (int n = 0; n < 2; ++n) _Pragma("unroll") for (int k = 0; k < 2; ++k) \
        acc[ai][bj][m][n] = __builtin_amdgcn_mfma_f32_16x16x32_bf16(Bt[n][k], At[m][k], acc[ai][bj][m][n], 0, 0, 0); __builtin_amdgcn_s_setprio(0); } while (0)
#define PG8_WAIT_V(n) asm volatile("s_waitcnt vmcnt(" #n ")" ::: "memory")
#define PG8_WAIT_L(n) asm volatile("s_waitcnt lgkmcnt(" #n ")" ::: "memory")
#define PG8_BAR __builtin_amdgcn_s_barrier()
#define PG8_SCHED __builtin_amdgcn_sched_barrier(0)
    Unit cur, nxt; int ui = 0;
    if (!S.next(0, cur)) return;
    f32x4 acc[2][2][4][2];
#pragma unroll
    for (int a = 0; a < 2; ++a)
#pragma unroll
        for (int b = 0; b < 2; ++b)
#pragma unroll
            for (int m = 0; m < 4; ++m)
#pragma unroll
                for (int n = 0; n < 2; ++n) acc[a][b][m][n] = (f32x4){0.f, 0.f, 0.f, 0.f};
    bf16x8 At[4][2], B0[2][2], B1[2][2];
    const char* cA = (const char*)g.A + (size_t)cur.pm * tstep + (size_t)cur.ks * cur.nt * (BK * 2); const char* cB = (const char*)g.Bt + (size_t)cur.pn * tstep + (size_t)cur.ks * cur.nt * (BK * 2);
    S.a_ready(cur);
    if constexpr (SP2) {
        PG8_STAGE(PG8_SB(0, 0), cB, voffB); PG8_STAGE(PG8_SB(0, 1), cB + hstep, voffB); PG8_STAGE(PG8_SA(0, 0), cA, voffA); PG8_STAGE(PG8_SA(0, 1), cA + hstep, voffA);
        if (wr == 1) PG8_BAR;
        PG8_WAIT_V(2); PG8_BAR;
        PG8_STAGE(PG8_SB(1, 0), cB + kstep, voffB); PG8_STAGE(PG8_SA(1, 0), cA + kstep, voffA); PG8_STAGE(PG8_SB(1, 1), cB + hstep + kstep, voffB);
        PG8_WAIT_V(6); PG8_BAR;
    } else {
        PG8_STAGE(PG8_SB(0, 0), cB, voffB); PG8_STAGE(PG8_SA(0, 0), cA, voffA); PG8_STAGE(PG8_SB(0, 1), cB + hstep, voffB); PG8_STAGE(PG8_SA(0, 1), cA + hstep, voffA);
        if (wr == 1) PG8_BAR;
        PG8_WAIT_V(4); PG8_BAR;
        PG8_STAGE(PG8_SB(1, 0), cB + kstep, voffB); PG8_STAGE(PG8_SA(1, 0), cA + kstep, voffA); PG8_STAGE(PG8_SB(1, 1), cB + hstep + kstep, voffB);
        PG8_WAIT_V(6); PG8_BAR;
    }
    for (;;) {
        const bool has_next = S.next(ui + 1, nxt);
        const char* nA = has_next ? (const char*)g.A + (size_t)nxt.pm * tstep + (size_t)nxt.ks * nxt.nt * (BK * 2) : cA; const char* nB = has_next ? (const char*)g.Bt + (size_t)nxt.pn * tstep + (size_t)nxt.ks * nxt.nt * (BK * 2) : cB;
        const int ntu = cur.nt ? cur.nt : nt;
        for (int t = 0; t < ntu; t += 2) {
            const bool last = (t == ntu - 2);
            const char* a1 = cA + (size_t)(t + 1) * kstep;
            const char* a2 = last ? nA : cA + (size_t)(t + 2) * kstep; const char* b2 = last ? nB : cB + (size_t)(t + 2) * kstep;
            const char* a3 = a2 + kstep; const char* b3 = b2 + kstep;
            if (last && has_next) S.a_ready(nxt);
            if constexpr (SP2) {
            PG8_LDB(B0, 0, 0); PG8_LDB(B1, 0, 1); PG8_SCHED; PG8_LDA(At, 0, 0); PG8_STAGE(PG8_SA(1, 1), a1 + hstep, voffA);
            PG8_WAIT_V(8); PG8_WAIT_L(0); PG8_BAR; PG8_MMA(0, 0, At, B0); PG8_MMA(0, 1, At, B1); PG8_BAR; PG8_SCHED;
            PG8_LDA(At, 0, 1); PG8_STAGE(PG8_SB(0, 0), b2, voffB); PG8_STAGE(PG8_SB(0, 1), b2 + hstep, voffB); PG8_STAGE(PG8_SA(0, 0), a2, voffA);
            PG8_WAIT_V(8); PG8_WAIT_L(0); PG8_BAR; PG8_MMA(1, 0, At, B0); PG8_MMA(1, 1, At, B1); PG8_BAR; PG8_SCHED;
            PG8_LDB(B0, 1, 0); PG8_LDB(B1, 1, 1); PG8_SCHED; PG8_LDA(At, 1, 0); PG8_STAGE(PG8_SA(0, 1), a2 + hstep, voffA);
            PG8_WAIT_V(8); PG8_WAIT_L(0); PG8_BAR; PG8_MMA(0, 0, At, B0); PG8_MMA(0, 1, At, B1); PG8_BAR; PG8_SCHED;
            PG8_LDA(At, 1, 1); PG8_STAGE(PG8_SB(1, 0), b3, voffB); PG8_STAGE(PG8_SB(1, 1), b3 + hstep, voffB); PG8_STAGE(PG8_SA(1, 0), a3, voffA);
            PG8_WAIT_V(8); PG8_WAIT_L(0); PG8_BAR; PG8_MMA(1, 0, At, B0); PG8_MMA(1, 1, At, B1); PG8_BAR; PG8_SCHED;
            } else {
            PG8_LDB(B0, 0, 0); PG8_SCHED; PG8_LDA(At, 0, 0); PG8_STAGE(PG8_SA(1, 1), a1 + hstep, voffA);
            PG8_WAIT_L(8); PG8_BAR; PG8_WAIT_L(0); PG8_MMA(0, 0, At, B0); PG8_BAR; PG8_SCHED;
            PG8_LDB(B1, 0, 1); PG8_STAGE(PG8_SB(0, 0), b2, voffB);
            PG8_BAR; PG8_WAIT_L(0); PG8_MMA(0, 1, At, B1); PG8_BAR;
            PG8_LDA(At, 0, 1); PG8_STAGE(PG8_SA(0, 0), a2, voffA);
            PG8_BAR; PG8_WAIT_L(0); PG8_MMA(1, 0, At, B0); PG8_BAR; PG8_SCHED;
            PG8_STAGE(PG8_SB(0, 1), b2 + hstep, voffB);
            PG8_WAIT_V(6); PG8_BAR; PG8_MMA(1, 1, At, B1); PG8_BAR;
            PG8_LDB(B0, 1, 0); PG8_SCHED; PG8_LDA(At, 1, 0); PG8_STAGE(PG8_SA(0, 1), a2 + hstep, voffA);
            PG8_WAIT_L(8); PG8_BAR; PG8_WAIT_L(0); PG8_MMA(0, 0, At, B0); PG8_BAR; PG8_SCHED;
            PG8_LDB(B1, 1, 1); PG8_STAGE(PG8_SB(1, 0), b3, voffB);
            PG8_BAR; PG8_WAIT_L(0); PG8_MMA(0, 1, At, B1); PG8_BAR;
            PG8_LDA(At, 1, 1); PG8_STAGE(PG8_SA(1, 0), a3, voffA);
            PG8_BAR; PG8_WAIT_L(0); PG8_MMA(1, 0, At, B0); PG8_BAR; PG8_SCHED;
            PG8_STAGE(PG8_SB(1, 1), b3 + hstep, voffB);
            PG8_WAIT_V(6); PG8_BAR; PG8_MMA(1, 1, At, B1); PG8_BAR;
            }
        }
        if constexpr (ALIGN_EPI) { if (wr == 0) PG8_BAR; }
        if constexpr (!Epi::AFTER_DRAIN) { E(acc, cur, wr, wc, fr, fq); S.done(cur); }
        if (!has_next) break;
#pragma unroll
        for (int a = 0; a < 2; ++a)
#pragma unroll
            for (int b = 0; b < 2; ++b)
#pragma unroll
                for (int m = 0; m < 4; ++m)
#pragma unroll
                    for (int n = 0; n < 2; ++n) acc[a][b][m][n] = (f32x4){0.f, 0.f, 0.f, 0.f};
        cur = nxt; cA = nA; cB = nB; ++ui;
        if constexpr (ALIGN_EPI) { if (wr == 1) PG8_BAR; }
    }
    PG8_WAIT_V(0);
    if constexpr (!ALIGN_EPI) { if (wr == 0) PG8_BAR; }
    PG8_BAR;
    if constexpr (Epi::AFTER_DRAIN) { E.fused(acc, cur, wr, wc, fr, fq, lds, wid, lane); S.done(cur); }
#undef PG8_SA
#undef PG8_SB
#undef PG8_STAGE
#undef PG8_LDA
#undef PG8_LDB
#undef PG8_MMA
#undef PG8_WAIT_V
#undef PG8_WAIT_L
#undef PG8_BAR
#undef PG8_SCHED
}
}
#define XB_TMO      128
#define XB_XCNT(j)  (256  + 64 * (j))
#define XB_XSUB(j)  (1280 + 64 * (j))
#define XB_XGEN(j)  (2304 + 64 * (j))
#define XB_TOP      3328
#define XB_TOPGEN   3392
#define XCD_BAR_WORDS 3456
#define XB_SPIN_CAP (1u << 18)

__device__ __forceinline__ unsigned xb_ld(unsigned* p)              { return __hip_atomic_load(p, __ATOMIC_RELAXED, __HIP_MEMORY_SCOPE_AGENT); }
__device__ __forceinline__ unsigned xb_add(unsigned* p, unsigned v) { return __hip_atomic_fetch_add(p, v, __ATOMIC_RELAXED, __HIP_MEMORY_SCOPE_AGENT); }
__device__ __forceinline__ unsigned xb_xcc_id() { return (unsigned)__builtin_amdgcn_s_getreg((3 << 11) | 20) & 0xFu; }
#define XB_SPIN(cond, bar) do { unsigned _sp = 0; while (cond) { __builtin_amdgcn_s_sleep(1); \
    if ((++_sp & 255u) == 0u) { if (xb_ld(&(bar)[XB_TMO])) break; if (_sp > XB_SPIN_CAP) { atomicAdd(&(bar)[XB_TMO], 1u); break; } } } } while (0)

struct XcdBarrier {
    unsigned* bar; unsigned x;
    volatile LAS unsigned* st;
};

__device__ __forceinline__ XcdBarrier xcd_barrier_post(unsigned* bar, volatile LAS unsigned* st) {
    XcdBarrier b; b.bar = bar; b.x = xb_xcc_id(); b.st = st;
    if (threadIdx.x == 0) (void)xb_add(&bar[XB_XCNT(b.x)], 1u);
    return b;
}
__device__ __forceinline__ void xcd_barrier_complete(unsigned* bar, unsigned x, unsigned& nloc, unsigned& nx) {
    const unsigned G = gridDim.x * gridDim.y * gridDim.z;
    unsigned sum, cnt, mine, sp = 0u;
    for (;;) {
        sum = 0u; cnt = 0u; mine = 0u;
#pragma unroll
        for (unsigned j = 0; j < 16; ++j) { const unsigned c = xb_ld(&bar[XB_XCNT(j)]); sum += c; cnt += (c > 0u) ? 1u : 0u; mine = (j == x) ? c : mine; }
        if (sum == G) break;
        __builtin_amdgcn_s_sleep(1);
        if ((++sp & 255u) == 0u) { if (xb_ld(&bar[XB_TMO])) break; if (sp > XB_SPIN_CAP) { atomicAdd(&bar[XB_TMO], 1u); break; } }
    }
    nloc = mine > 0u ? mine : 1u; nx = cnt > 0u ? cnt : 1u;
}

__device__ __forceinline__ void xcd_barrier(const XcdBarrier& b) {
    asm volatile("s_waitcnt vmcnt(0)" ::: "memory");
    __syncthreads();
    if (threadIdx.x == 0) {
        unsigned* bar = b.bar;
        __builtin_amdgcn_s_waitcnt(0);
        unsigned nloc = b.st[0], nx = b.st[1];
        if (nloc == 0u) { xcd_barrier_complete(bar, b.x, nloc, nx); b.st[0] = nloc; b.st[1] = nx; }
        const unsigned old = xb_add(&bar[XB_XSUB(b.x)], 1u);
        const unsigned gen = old / nloc;
        if (old + 1u == (gen + 1u) * nloc) {
            __builtin_amdgcn_fence(__ATOMIC_RELEASE, "agent");
            asm volatile("s_waitcnt vmcnt(0)" ::: "memory");
            const unsigned og = xb_add(&bar[XB_TOP], 1u);
            const unsigned tg = og / nx;
            if (og + 1u == (tg + 1u) * nx) xb_add(&bar[XB_TOPGEN], 1u);
            else XB_SPIN(xb_ld(&bar[XB_TOPGEN]) == tg, bar);
            __builtin_amdgcn_fence(__ATOMIC_ACQUIRE, "agent");
            xb_add(&bar[XB_XGEN(b.x)], 1u);
            asm volatile("s_waitcnt vmcnt(0)" ::: "memory");
        } else {
            XB_SPIN(xb_ld(&bar[XB_XGEN(b.x)]) == gen, bar);
            __builtin_amdgcn_fence(__ATOMIC_ACQUIRE, "agent");
            asm volatile("s_waitcnt vmcnt(0)" ::: "memory");
        }
    }
    __syncthreads();
}
namespace cg = cooperative_groups;
#define LAS __attribute__((address_space(3)))
typedef unsigned short bf16_t;
typedef short bf16x8 __attribute__((ext_vector_type(8)));
typedef short s16x4 __attribute__((ext_vector_type(4)));
typedef float f32x4 __attribute__((ext_vector_type(4)));
typedef float f32x16 __attribute__((ext_vector_type(16)));
typedef unsigned u32x4 __attribute__((ext_vector_type(4)));
typedef unsigned u32x2 __attribute__((ext_vector_type(2)));

constexpr int DM = 2048, MP = 16384, MS = 1024, M = MP + MS;
constexpr int DFF = 5632, NUP = 2 * DFF, NIN = 6400  , NINR = 6160;
constexpr float EPS = 1e-6f;
constexpr int NWAVES = 8;
constexpr int LDS_BYTES = 147456;
constexpr size_t OUT_Y = 0, OUT_GLAP = 35651584, OUT_GLAS = 39845888, OUT_CONVP = 56623104, OUT_CONVS = 56803328,
                 OUT_KP = 57524224, OUT_VP = 58572800, OUT_KS = 59621376, OUT_VS = 60145664;
constexpr size_t MiB = 1u << 20;
constexpr size_t WS_WIN = 0;
constexpr size_t WS_GWO = 50 * MiB;
constexpr size_t WS_WKVQ = 66 * MiB;
constexpr size_t WS_WQ3 = 78 * MiB;
constexpr size_t WS_AWO = 86 * MiB;
constexpr size_t WS_WUP = 102 * MiB;
constexpr size_t WS_WDN = 278 * MiB;
constexpr size_t WS_H = 366 * MiB;
constexpr size_t WS_MF = 434 * MiB;
constexpr size_t WS_KVP = 570 * MiB;
constexpr size_t WS_KVS = 602 * MiB;
constexpr size_t WS_HF = 620 * MiB;
constexpr size_t WS_O = WS_HF, WS_OG = WS_HF + 68 * MiB, WS_Q = WS_HF;
constexpr size_t WS_SCR = 808 * MiB;
constexpr size_t WS_U = WS_SCR, WS_PROJ = WS_SCR, WS_GPRE = WS_SCR + 213 * MiB;
constexpr size_t GPRE_ITEM = 32768 + 8192 + 65536 + 1024 + 32768;
constexpr size_t WS_UST = WS_H;
constexpr size_t WS_END = WS_SCR + 374 * MiB;
static_assert(WS_GPRE + 1088 * GPRE_ITEM <= WS_END, "gpre fits");
static_assert(WS_UST + (size_t)1088 * 262144 <= WS_OG, "ust fits below OG");
constexpr size_t WS_CTL = WS_END, CTL_BYTES = 65536, WS_END2 = WS_END + MiB;
constexpr size_t WS_GT = WS_END2, WS_GH = WS_GT + 13 * MiB, WS_VH = WS_GH + 13 * MiB, WS_END3 = WS_VH + 13 * MiB;
constexpr size_t WS_MFP = WS_END3, WS_END4 = WS_MFP + 64 * MiB;
constexpr size_t WS_XB = WS_END4, WS_END5 = WS_XB + 68 * MiB;
constexpr size_t WS_RS = WS_END5, WS_END6 = WS_RS + MiB;
constexpr int LDS_BARST = 147392;

__device__ __forceinline__ float bf2f(unsigned v) { return __uint_as_float(v << 16); }
__device__ __forceinline__ unsigned f2bf_sw(float f) { unsigned u = __float_as_uint(f); return (u + 0x7fffu + ((u >> 16) & 1u)) >> 16; }
typedef float f32x2_t __attribute__((ext_vector_type(2))); typedef __bf16 bf16x2_t __attribute__((ext_vector_type(2)));
__device__ __forceinline__ unsigned pk2(float lo, float hi) { f32x2_t v = {lo, hi}; bf16x2_t b = __builtin_convertvector(v, bf16x2_t); return __builtin_bit_cast(unsigned, b); }
__device__ __forceinline__ unsigned pk2_sw(float lo, float hi) { return pk2(lo, hi); }
__device__ __forceinline__ unsigned f2bf(float f) { return pk2(f, f) & 0xffffu; }
__device__ __forceinline__ float wave_sum(float v) {
#pragma unroll
    for (int o = 1; o < 64; o <<= 1) v += __shfl_xor(v, o);
    return v;
}
__device__ __forceinline__ float silu_f(float x) { return x * __builtin_amdgcn_rcpf(1.f + __expf(-x)); }

#define LDS_BARRIER() asm volatile("s_waitcnt lgkmcnt(0)\n\ts_barrier" ::: "memory")
struct Args { const float* in[21]; float* out; unsigned char* ws; int ph_lo, ph_hi; };
typedef const Args __attribute__((address_space(4))) CArgs;
__device__ __forceinline__ CArgs* get_args() { CArgs* p = (CArgs*)__builtin_amdgcn_kernarg_segment_ptr(); asm volatile("" : "+s"(p)); return p; }

__device__ __forceinline__ void tr_load(f32x4 (&v)[16], float (&gv)[16], const float* W, int ldw, int ncols, const float* gain, int item, int lane) {
    const int nblk = ncols / 64, kb = item / nblk, nb = item % nblk, k0 = 64 * kb, n0 = 64 * nb, l16 = lane & 15, r2 = lane >> 4;
#pragma unroll
    for (int j = 0; j < 16; ++j) v[j] = __builtin_nontemporal_load((const f32x4*)(W + (size_t)(k0 + 8 * (j >> 1) + 2 * r2 + (j & 1)) * ldw + n0 + 4 * l16));
#pragma unroll
    for (int j = 0; j < 16; ++j) gv[j] = gain ? gain[k0 + 8 * (j >> 1) + 2 * r2 + (j & 1)] : 1.f;
}
__device__ __forceinline__ void tr_store(const f32x4 (&v)[16], const float (&gv)[16], int K, int ncols, int qcols, float qscale, bf16_t* WT, LAS unsigned* scr, int item, int lane, int permup) {
    const int nblk = ncols / 64, kb = item / nblk, nb = item % nblk, k0 = 64 * kb, n0 = 64 * nb;
    const float sc = (n0 < qcols) ? qscale : 1.f;
    const int nd0 = permup ? 256 * ((n0 % 5632) / 128) + 128 * (n0 / 5632) + (n0 % 128) : n0;
    const int l16 = lane & 15, r2 = lane >> 4;
#pragma unroll
    for (int jp = 0; jp < 8; ++jp) {
        const float g0 = gv[2 * jp] * sc, g1 = gv[2 * jp + 1] * sc;
#pragma unroll
        for (int i = 0; i < 4; ++i) scr[(4 * l16 + i) * 33 + 4 * jp + r2] = pk2(v[2 * jp][i] * g0, v[2 * jp + 1][i] * g1);
    }
    asm volatile("s_waitcnt lgkmcnt(0)" ::: "memory");
    const int c = lane & 7;
#pragma unroll
    for (int jj = 0; jj < 8; ++jj) { const int n = (lane >> 3) + 8 * jj; const LAS unsigned* s = scr + n * 33 + 4 * c;
        u32x4 o; o.x = s[0]; o.y = s[1]; o.z = s[2]; o.w = s[3];
        *(u32x4*)(WT + (size_t)(nd0 + n) * K + k0 + 8 * c) = o; }
    asm volatile("s_waitcnt lgkmcnt(0)" ::: "memory");
}

__device__ __forceinline__ void kvs_cache_convert(CArgs* a, int vcu, int G) {
    const int tid = opq_tid(); unsigned char* ws = a->ws;
    const int gt = vcu * 512 + tid, NT = G * 512;
    for (int i = gt; i < 16 * 512 * 128; i += NT) {
        const int bp = i >> 7, c4 = (i & 127) * 4;
        const f32x4 kv = *(const f32x4*)(a->in[4] + (size_t)bp * 512 + c4), vv = *(const f32x4*)(a->in[5] + (size_t)bp * 512 + c4);
        const int b = bp >> 9, p = bp & 511;
        bf16_t* dst = (bf16_t*)(ws + WS_KVS) + ((size_t)b * 576 + p) * 1024 + c4;
        u32x2 w; w.x = pk2(kv[0], kv[1]); w.y = pk2(kv[2], kv[3]); *(u32x2*)dst = w;
        w.x = pk2(vv[0], vv[1]); w.y = pk2(vv[2], vv[3]); *(u32x2*)(dst + 512) = w;
    }
}

#define P0_JOB(idx_, jW, jldw, jK, jncols, jgain, jqcols, jqscale, jWT, jperm, jit) do { int r_ = (idx_), j_ = 0; \
        if (r_ >= 3072) { r_ -= 3072; j_ = 1; if (r_ >= 3072) { r_ -= 3072; j_ = 2; if (r_ >= 1024) { r_ -= 1024; j_ = 3; if (r_ >= 1024) { r_ -= 1024; j_ = 4; if (r_ >= 512) { r_ -= 512; j_ = 5; \
        if (r_ >= 1024) { r_ -= 1024; j_ = 6; if (r_ >= 1024) { r_ -= 1024; j_ = 7; if (r_ >= 1024) { r_ -= 1024; j_ = 8; if (r_ >= 1024) { r_ -= 1024; j_ = 9 + r_ / 5632; r_ = r_ % 5632; \
        if (j_ >= 13) { r_ = (idx_) - 35328; j_ = 13 + r_ / 2816; r_ = r_ % 2816; } } } } } } } } } } \
        jit = r_; jqcols = 0; jgain = nullptr; jqscale = 1.f; jperm = 0; const int j = j_; \
        if (j < 2)       { jW = a->in[7] + (size_t)j * 2048 * NINR; jldw = NINR; jK = 2048; jncols = 6144; jgain = gains + (j * 4 + 0) * 2048; jqcols = 1024; jqscale = 0.0625f; jWT = (bf16_t*)(ws + WS_WIN) + (size_t)j * NIN * 2048; } \
        else if (j < 4)  { const int l = j - 2; jW = a->in[11] + (size_t)l * 2048 * 2048; jldw = 2048; jK = 2048; jncols = 2048; jWT = (bf16_t*)(ws + WS_GWO) + (size_t)l * 2048 * 2048; } \
        else if (j == 4) { jW = a->in[13]; jldw = 1024; jK = 2048; jncols = 1024; jgain = a->in[12]; jWT = (bf16_t*)(ws + WS_WKVQ); } \
        else if (j == 5) { jW = a->in[14]; jldw = 2048; jK = 2048; jncols = 2048; jgain = gains + (2 * 4 + 0) * 2048; jqcols = 2048; jqscale = 0.12751743074602625f  ; jWT = (bf16_t*)(ws + WS_WKVQ) + (size_t)1024 * 2048; } \
        else if (j == 6) { jW = a->in[14] + (size_t)2048 * 2048; jldw = 2048; jK = 2048; jncols = 2048; jgain = gains + (3 * 4 + 0) * 2048; jqcols = 2048; jqscale = 0.12751743074602625f; jWT = (bf16_t*)(ws + WS_WQ3); } \
        else if (j < 9)  { const int l = j - 7; jW = a->in[16] + (size_t)l * 2048 * 2048; jldw = 2048; jK = 2048; jncols = 2048; jWT = (bf16_t*)(ws + WS_AWO) + (size_t)l * 2048 * 2048; } \
        else if (j < 13) { const int l = j - 9; jW = a->in[17] + (size_t)l * 2048 * NUP; jldw = NUP; jK = 2048; jncols = NUP; jgain = gains + (l * 4 + 2) * 2048; jWT = (bf16_t*)(ws + WS_WUP) + (size_t)l * NUP * 2048; jperm = 1; } \
        else             { const int l = j - 13; jW = a->in[20] + (size_t)l * DFF * 2048; jldw = 2048; jK = DFF; jncols = 2048; jWT = (bf16_t*)(ws + WS_WDN) + (size_t)l * 2048 * DFF; } } while (0)
__device__ __forceinline__ int layer_tile(int L, int v) {
    if (L < 2) { if (v < 3072) return L * 3072 + v; v -= 3072; if (v < 1024) return 6144 + L * 1024 + v; v -= 1024; if (v < 5632) return 12800 + L * 5632 + v; v -= 5632; return 35328 + L * 2816 + v; }
    if (L == 2) { if (v < 512) return 8192 + v; v -= 512; if (v < 1024) return 8704 + v; v -= 1024; if (v < 1024) return 10752 + v; v -= 1024; if (v < 5632) return 12800 + 2 * 5632 + v; v -= 5632; return 35328 + 2 * 2816 + v; }
    if (v < 1024) return 9728 + v; v -= 1024; if (v < 1024) return 11776 + v; v -= 1024; if (v < 5632) return 12800 + 3 * 5632 + v; v -= 5632; return 35328 + 3 * 2816 + v;
}
__device__ __forceinline__ void convert_layer_tiles(CArgs* a, LAS unsigned char* lds, int L, int v0, int v1, int widx, int nw) {
    const int tid = opq_tid(), lane = tid & 63, wave = __builtin_amdgcn_readfirstlane(tid >> 6);
    LAS unsigned* scr = (LAS unsigned*)(lds + wave * 16384);
    unsigned char* ws = a->ws; const float* gains = a->in[6];
    f32x4 v[16], vn[16]; float gv[16], gn[16];
    const float* cW; int cldw, cK, cncols, cqcols, cperm, cit; const float* cgain; float cqscale; bf16_t* cWT;
    int vi = v0 + widx;
    if (vi < v1) { P0_JOB(layer_tile(L, vi), cW, cldw, cK, cncols, cgain, cqcols, cqscale, cWT, cperm, cit); tr_load(v, gv, cW, cldw, cncols, cgain, cit, lane); }
    while (vi < v1) {
        const int nx = vi + nw;
        const float* nW = cW; int nldw = cldw, nK = cK, nncols = cncols, nqcols = cqcols, nperm = cperm, nit = cit; const float* ngain = cgain; float nqscale = cqscale; bf16_t* nWT = cWT;
        if (nx < v1) { P0_JOB(layer_tile(L, nx), nW, nldw, nK, nncols, ngain, nqcols, nqscale, nWT, nperm, nit); tr_load(vn, gn, nW, nldw, nncols, ngain, nit, lane); }
        tr_store(v, gv, cK, cncols, cqcols, cqscale, cWT, scr, cit, lane, cperm);
#pragma unroll
        for (int q = 0; q < 16; ++q) { v[q] = vn[q]; gv[q] = gn[q]; }
        cW = nW; cldw = nldw; cK = nK; cncols = nncols; cgain = ngain; cqcols = nqcols; cqscale = nqscale; cWT = nWT; cperm = nperm; cit = nit;
        vi = nx;
    }
}
__device__ __forceinline__ void convert_in_phase(CArgs* a, LAS unsigned char* lds, int G, int bx, int l, int rem, int pf0, int pf1, int LL = -1, int q0 = 0, int q1 = 0) {
    if (G != 256 || bx < rem) return;
    if (LL < 0 && l >= 3) return;
    const int L = LL >= 0 ? LL : l + 1;
    const int NT = (L < 2) ? 12544 : (L == 2 ? 11008 : 10496);
    const int p0 = LL >= 0 ? q0 : (int)((long)NT * pf0 / 1024), p1 = LL >= 0 ? q1 : (int)((long)NT * pf1 / 1024), nI = 256 - rem, cnt = (p1 - p0 + nI - 1) / nI;
    const int v0 = p0 + (bx - rem) * cnt, v1 = (v0 + cnt < p1) ? v0 + cnt : p1;
    const int wave = __builtin_amdgcn_readfirstlane((int)(threadIdx.x >> 6));
    __syncthreads();
    convert_layer_tiles(a, lds, L, v0, v1, wave, 8);
}
__device__ __forceinline__ void p0_prologue(CArgs* a, LAS unsigned char* lds, int vcu, int G) {
    const int tid = opq_tid(), lane = tid & 63, wave = __builtin_amdgcn_readfirstlane(tid >> 6);
    LAS unsigned* scr = (LAS unsigned*)(lds + wave * 16384);
    const int gw = vcu * NWAVES + wave, NGW = G * NWAVES;
    unsigned char* ws = a->ws;
    const float* gains = a->in[6];
    if (G == 256) convert_layer_tiles(a, lds, 0, 0, 3072, gw, NGW);
    else { convert_layer_tiles(a, lds, 0, 0, 12544, gw, NGW); convert_layer_tiles(a, lds, 1, 0, 12544, gw, NGW); convert_layer_tiles(a, lds, 2, 0, 11008, gw, NGW); convert_layer_tiles(a, lds, 3, 0, 10496, gw, NGW); }
    const int gt = vcu * 512 + tid, NT = G * 512;
    for (int i = gt; i < 2 * 2048 * 256; i += NT) {
        const int l = i / (2048 * 256), r = i % (2048 * 256), n = r / 2048, k = r % 2048;
        float v = 0.f;
        if (n < 16) v = a->in[7][((size_t)l * 2048 + k) * NINR + 6144 + n] * gains[(l * 4 + 0) * 2048 + k];
        ((bf16_t*)(ws + WS_WIN))[((size_t)l * NIN + 6144 + n) * 2048 + k] = (bf16_t)f2bf(v);
    }
    {
        f32x4 v[8], vn[8];
        int row = gw;
        if (row < M) { const float* xr = row < MP ? a->in[0] + (size_t)row * DM : a->in[1] + (size_t)(row - MP) * DM;
#pragma unroll
            for (int j = 0; j < 8; ++j) v[j] = __builtin_nontemporal_load((const f32x4*)(xr + 4 * lane + 256 * j)); }
        for (; row < M; row += NGW) {
            const int nr = row + NGW;
            if (nr < M) { const float* xr = nr < MP ? a->in[0] + (size_t)nr * DM : a->in[1] + (size_t)(nr - MP) * DM;
#pragma unroll
                for (int j = 0; j < 8; ++j) vn[j] = __builtin_nontemporal_load((const f32x4*)(xr + 4 * lane + 256 * j)); }
            float s = 0.f;
#pragma unroll
            for (int j = 0; j < 8; ++j) s += (v[j][0] * v[j][0] + v[j][1] * v[j][1]) + (v[j][2] * v[j][2] + v[j][3] * v[j][3]);
            const float r = rsqrtf(wave_sum(s) * (1.f / DM) + EPS);
            bf16_t* hr = (bf16_t*)(ws + WS_XB) + (size_t)row * DM;
#pragma unroll
            for (int j = 0; j < 8; ++j) { u32x2 w; w.x = pk2(v[j][0], v[j][1]); w.y = pk2(v[j][2], v[j][3]); *(u32x2*)(hr + 4 * lane + 256 * j) = w; }
            if (lane == 0) ((float*)(ws + WS_RS))[row] = r;
#pragma unroll
            for (int j = 0; j < 8; ++j) v[j] = vn[j];
        }
    }
}

template <bool LAST> __device__ __forceinline__ void norm_row(f32x4 (&xv)[8], const f32x4 (&mv)[8], const f32x4 (&g)[8], float* xo32, bf16_t* xo16, bf16_t* hr, int lane) {
    constexpr bool want_h = !LAST;
    float s = 0.f;
#pragma unroll
    for (int j = 0; j < 8; ++j) s += (mv[j][0] * mv[j][0] + mv[j][1] * mv[j][1]) + (mv[j][2] * mv[j][2] + mv[j][3] * mv[j][3]);
    const float r1 = rsqrtf(wave_sum(s) * (1.f / DM) + EPS);
    float s2 = 0.f;
#pragma unroll
    for (int j = 0; j < 8; ++j) { xv[j] = xv[j] + mv[j] * r1 * g[j];
        s2 += (xv[j][0] * xv[j][0] + xv[j][1] * xv[j][1]) + (xv[j][2] * xv[j][2] + xv[j][3] * xv[j][3]);
        if (LAST) *(f32x4*)(xo32 + 4 * lane + 256 * j) = xv[j];
        else { u32x2 w; w.x = pk2(xv[j][0], xv[j][1]); w.y = pk2(xv[j][2], xv[j][3]); *(u32x2*)(xo16 + 4 * lane + 256 * j) = w; } }
    if (want_h) {
        const float r2 = rsqrtf(wave_sum(s2) * (1.f / DM) + EPS);
        if (lane == 0) *(float*)hr = r2;
    }
}
__device__ __forceinline__ f32x4 unpk4(u32x2 p) { return (f32x4){bf2f(p.x & 0xffffu), bf2f(p.x >> 16), bf2f(p.y & 0xffffu), bf2f(p.y >> 16)}; }
__device__ __forceinline__ void norm_pass(CArgs* a, LAS unsigned char* lds, int vcu, int G, const float* gpost, bool first, bool want_h, int nsplit) {
    const int tid = opq_tid(), lane = tid & 63, wave = tid >> 6;
    const int gw = vcu * NWAVES + wave, NGW = G * NWAVES;
    float* Y = a->out + OUT_Y; bf16_t* XB = (bf16_t*)(a->ws + WS_XB); const bf16_t* MF = (const bf16_t*)(a->ws + WS_MF); float* RS = (float*)(a->ws + WS_RS);
    const bool last = !want_h;
    f32x4 g[8];
#pragma unroll
    for (int j = 0; j < 8; ++j) g[j] = *(const f32x4*)(gpost + 4 * lane + 256 * j);
    if (first) {
        for (int row = gw; row < MP; row += NGW) {
            f32x4 xv[8], mv[8];
#pragma unroll
            for (int j = 0; j < 8; ++j) { xv[j] = *(const f32x4*)(a->in[0] + (size_t)row * DM + 4 * lane + 256 * j); mv[j] = unpk4(*(const u32x2*)(MF + (size_t)row * DM + 4 * lane + 256 * j)); }
            norm_row<false>(xv, mv, g, nullptr, XB + (size_t)row * DM, (bf16_t*)(RS + row), lane);
        }
    } else {
        u32x2 xa[8], xb[8], xc[8], ma[8], mb[8], mc[8];
        int row = gw;
#define NP_LOAD(xd, md, r_) do { _Pragma("unroll") for (int j = 0; j < 8; ++j) { xd[j] = *(const u32x2*)(XB + (size_t)(r_) * DM + 4 * lane + 256 * j); md[j] = *(const u32x2*)(MF + (size_t)(r_) * DM + 4 * lane + 256 * j); } } while (0)
        if (row < MP) NP_LOAD(xa, ma, row);
        if (row + NGW < MP) NP_LOAD(xb, mb, row + NGW);
        for (; row < MP; row += NGW) {
            const int nr = row + 2 * NGW;
            if (nr < MP) NP_LOAD(xc, mc, nr);
            f32x4 xv[8], mv[8];
#pragma unroll
            for (int j = 0; j < 8; ++j) { xv[j] = unpk4(xa[j]); mv[j] = unpk4(ma[j]); }
            if (last) norm_row<true>(xv, mv, g, Y + (size_t)row * DM, nullptr, nullptr, lane); else norm_row<false>(xv, mv, g, nullptr, XB + (size_t)row * DM, (bf16_t*)(RS + row), lane);
#pragma unroll
            for (int j = 0; j < 8; ++j) { xa[j] = xb[j]; ma[j] = mb[j]; xb[j] = xc[j]; mb[j] = mc[j]; }
        }
#undef NP_LOAD
    }
    if (G == 256) {
        LAS float* red = (LAS float*)lds;
        const int rl = wave & 3, hf = wave >> 2, row = MP + 4 * vcu + rl, c0 = 1024 * hf + 4 * lane;
        f32x4 xv[4], mv[4];
#pragma unroll
        for (int j = 0; j < 4; ++j) { xv[j] = unpk4(*(const u32x2*)(XB + (size_t)row * DM + c0 + 256 * j)); mv[j] = (f32x4){0.f, 0.f, 0.f, 0.f}; }
        const float* pp = (const float*)(a->ws + WS_MFP) + (size_t)(row - MP) * DM + c0;
        if (nsplit == 8) { f32x4 p[8][4];
#pragma unroll
            for (int sp = 0; sp < 8; ++sp)
#pragma unroll
                for (int j = 0; j < 4; ++j) p[sp][j] = *(const f32x4*)(pp + (size_t)sp * MS * DM + 256 * j);
#pragma unroll
            for (int j = 0; j < 4; ++j) mv[j] = ((p[0][j] + p[1][j]) + (p[2][j] + p[3][j])) + ((p[4][j] + p[5][j]) + (p[6][j] + p[7][j])); }
        else { f32x4 p[4][4];
#pragma unroll
            for (int sp = 0; sp < 4; ++sp)
#pragma unroll
                for (int j = 0; j < 4; ++j) p[sp][j] = *(const f32x4*)(pp + (size_t)sp * MS * DM + 256 * j);
#pragma unroll
            for (int j = 0; j < 4; ++j) mv[j] = (p[0][j] + p[1][j]) + (p[2][j] + p[3][j]); }
        float s = 0.f;
#pragma unroll
        for (int j = 0; j < 4; ++j) s += (mv[j][0] * mv[j][0] + mv[j][1] * mv[j][1]) + (mv[j][2] * mv[j][2] + mv[j][3] * mv[j][3]);
        s = wave_sum(s);
        __syncthreads();
        if (lane == 0) red[rl * 2 + hf] = s;
        __syncthreads();
        const float r1 = rsqrtf((red[rl * 2] + red[rl * 2 + 1]) * (1.f / DM) + EPS);
        float s2 = 0.f;
#pragma unroll
        for (int j = 0; j < 4; ++j) { const f32x4 gg = *(const f32x4*)(gpost + c0 + 256 * j); xv[j] = xv[j] + mv[j] * r1 * gg;
            s2 += (xv[j][0] * xv[j][0] + xv[j][1] * xv[j][1]) + (xv[j][2] * xv[j][2] + xv[j][3] * xv[j][3]);
            if (last) *(f32x4*)(Y + (size_t)row * DM + c0 + 256 * j) = xv[j];
            else { u32x2 w; w.x = pk2(xv[j][0], xv[j][1]); w.y = pk2(xv[j][2], xv[j][3]); *(u32x2*)(XB + (size_t)row * DM + c0 + 256 * j) = w; } }
        if (!last) {
            s2 = wave_sum(s2);
            if (lane == 0) red[8 + rl * 2 + hf] = s2;
            __syncthreads();
            if (hf == 0 && lane == 0) RS[row] = rsqrtf((red[8 + rl * 2] + red[8 + rl * 2 + 1]) * (1.f / DM) + EPS);
        }
    } else {
#pragma unroll 1
    for (int row = MP + gw; row < M; row += NGW) {
        f32x4 xv[8], mv[8];
#pragma unroll
        for (int j = 0; j < 8; ++j) { xv[j] = unpk4(*(const u32x2*)(XB + (size_t)row * DM + 4 * lane + 256 * j)); mv[j] = (f32x4){0.f, 0.f, 0.f, 0.f}; }
#pragma unroll 1
        for (int sp = 0; sp < nsplit; sp += 2) {
            const float* pp = (const float*)(a->ws + WS_MFP) + (size_t)sp * MS * DM + (size_t)(row - MP) * DM + 4 * lane;
            f32x4 p0[8], p1[8];
#pragma unroll
            for (int j = 0; j < 8; ++j) { p0[j] = *(const f32x4*)(pp + 256 * j); p1[j] = *(const f32x4*)(pp + (size_t)MS * DM + 256 * j); }
#pragma unroll
            for (int j = 0; j < 8; ++j) mv[j] = mv[j] + (p0[j] + p1[j]);
        }
        if (last) norm_row<true>(xv, mv, g, Y + (size_t)row * DM, nullptr, nullptr, lane); else norm_row<false>(xv, mv, g, nullptr, XB + (size_t)row * DM, (bf16_t*)(RS + row), lane);
    }
    }
}

__device__ __forceinline__ void conv_pass(CArgs* a, int vcu, int G, int l) {
    const int tid = opq_tid();
    const int gt = vcu * 512 + tid, NT = G * 512;
    bf16_t* HF = (bf16_t*)(a->ws + WS_HF);
    const float* GT = (const float*)(a->ws + WS_GT); const float* GH = (const float*)(a->ws + WS_GH); const float* VH = (const float*)(a->ws + WS_VH);
    const float* cw = a->in[18] + (size_t)l * 3 * DFF; const float* cb = a->in[19] + (size_t)l * DFF;
    for (int i = gt; i < 272 * 1408; i += NT) {
        const int rb = i / 1408, j0 = (i % 1408) * 4;
        const f32x4 w0 = *(const f32x4*)(cw + j0), w1 = *(const f32x4*)(cw + DFF + j0), w2 = *(const f32x4*)(cw + 2 * DFF + j0), bb = *(const f32x4*)(cb + j0);
        f32x4 gm2 = (f32x4){0.f, 0.f, 0.f, 0.f}, gm1 = gm2;
        if (rb >= 256) { const float* st = a->in[3] + ((size_t)(l * 16 + (rb - 256)) * 2) * DFF + j0; gm2 = *(const f32x4*)st; gm1 = *(const f32x4*)(st + DFF); }
        else if ((rb & 63) != 0) { gm2 = *(const f32x4*)(GT + ((size_t)(rb - 1) * 2) * DFF + j0); gm1 = *(const f32x4*)(GT + ((size_t)(rb - 1) * 2 + 1) * DFF + j0); }
        const f32x4 g0 = *(const f32x4*)(GH + ((size_t)rb * 2) * DFF + j0), g1 = *(const f32x4*)(GH + ((size_t)rb * 2 + 1) * DFF + j0);
        const f32x4 v0 = *(const f32x4*)(VH + ((size_t)rb * 2) * DFF + j0), v1 = *(const f32x4*)(VH + ((size_t)rb * 2 + 1) * DFF + j0);
        const f32x4 c0 = bb + w0 * gm2 + w1 * gm1 + w2 * g0, c1 = bb + w0 * gm1 + w1 * g0 + w2 * g1;
        u32x2 o0, o1;
        o0.x = pk2(silu_f(c0[0]) * v0[0], silu_f(c0[1]) * v0[1]); o0.y = pk2(silu_f(c0[2]) * v0[2], silu_f(c0[3]) * v0[3]);
        o1.x = pk2(silu_f(c1[0]) * v1[0], silu_f(c1[1]) * v1[1]); o1.y = pk2(silu_f(c1[2]) * v1[2], silu_f(c1[3]) * v1[3]);
        *(u32x2*)(HF + (size_t)(rb * 64) * DFF + j0) = o0; *(u32x2*)(HF + (size_t)(rb * 64 + 1) * DFF + j0) = o1;
        float* cout = nullptr;
        if (rb >= 256) cout = a->out + OUT_CONVS + ((size_t)(l * 16 + (rb - 256)) * 2) * DFF + j0;
        else if ((rb & 63) == 63) cout = a->out + OUT_CONVP + ((size_t)(l * 4 + (rb >> 6)) * 2) * DFF + j0;
        if (cout) { *(f32x4*)cout = *(const f32x4*)(GT + ((size_t)rb * 2) * DFF + j0); *(f32x4*)(cout + DFF) = *(const f32x4*)(GT + ((size_t)rb * 2 + 1) * DFF + j0); }
    }
}

constexpr size_t GP_QI = 0, GP_P = 32768, GP_VT = 40960, GP_DEC = 106496, GP_KET = 107520;
__device__ __forceinline__ void gla_pre(CArgs* a, LAS unsigned char* lds, int vcu, int G, int l) {
    const int tid = opq_tid(), lane = tid & 63, wave = __builtin_amdgcn_readfirstlane(tid >> 6);
    LAS float* glow = (LAS float*)lds;
    LAS float* tot = (LAS float*)(lds + 4096);
    LAS float* BcL = (LAS float*)(lds + 8192);
    LAS bf16_t* QaL = (LAS bf16_t*)(lds + 73728);
    LAS bf16_t* KeL = (LAS bf16_t*)(lds + 107520);
    LAS bf16_t* KeTL = (LAS bf16_t*)(lds + 8192);
    LAS unsigned* VTLw = (LAS unsigned*)(lds + 45056);
    LAS bf16_t* VTL = (LAS bf16_t*)(lds + 45056);
    const bf16_t* PROJ = (const bf16_t*)(a->ws + WS_PROJ);
    const float* wgate = a->in[8] + (size_t)l * 16 * 1024; const float* bgate = a->in[9] + (size_t)l * 1024;
    for (int it = vcu; it < 1088; it += G) {
        int row0, h;
        if (it < 1024) { const int s = it >> 6, c = it & 63; h = s & 3; row0 = (s >> 2) * 4096 + c * 64; }
        else { const int s = it - 1024; h = s & 3; row0 = MP + (s >> 2) * 64; }
        const bf16_t* P = PROJ + (size_t)row0 * NIN;
        unsigned char* gp = a->ws + WS_GPRE + (size_t)it * GPRE_ITEM;
        bf16_t* Qi = (bf16_t*)(gp + GP_QI); bf16_t* Pg = (bf16_t*)(gp + GP_P); bf16_t* VT = (bf16_t*)(gp + GP_VT); float* dec = (float*)(gp + GP_DEC);
        __syncthreads();
        for (int i = tid; i < 1024; i += 512) glow[i] = bf2f(P[(size_t)(i >> 4) * NIN + 6144 + (i & 15)]);
        u32x4 qpre[4], kpre[4];
#pragma unroll
        for (int jj = 0; jj < 4; ++jj) { qpre[jj] = *(const u32x4*)(P + (size_t)(tid >> 3) * NIN + h * 256 + (tid & 7) * 32 + 8 * jj); kpre[jj] = *(const u32x4*)(P + (size_t)(tid >> 3) * NIN + 1024 + h * 256 + (tid & 7) * 32 + 8 * jj); }
        __syncthreads();
        {
            const int c = tid & 255, half = tid >> 8, col = h * 256 + c;
            float wg[16];
#pragma unroll
            for (int r = 0; r < 16; ++r) wg[r] = wgate[r * 1024 + col];
            const float bgv = bgate[col];
            float run = 0.f;
#pragma unroll 2
            for (int i = 0; i < 32; ++i) {
                const int t = half * 32 + i; float z = bgv;
#pragma unroll
                for (int r4 = 0; r4 < 4; ++r4) { const f32x4 gl = *(const LAS f32x4*)(glow + t * 16 + 4 * r4); z += gl[0] * wg[4 * r4] + gl[1] * wg[4 * r4 + 1] + gl[2] * wg[4 * r4 + 2] + gl[3] * wg[4 * r4 + 3]; }
                const float gk = -(fmaxf(-z, 0.f) + __logf(1.f + __expf(-fabsf(z)))) * 0.0625f;
                run += gk; BcL[t * 256 + c] = run;
            }
            tot[half * 256 + c] = run;
        }
        __syncthreads();
        {
            const int t = tid >> 3, c0 = (tid & 7) * 32;
#pragma unroll
            for (int jj = 0; jj < 4; ++jj) {
                const int c = c0 + 8 * jj;
                const u32x4 qv = qpre[jj], kv = kpre[jj];
                float bt[8], be[8];
                { const f32x4 b0 = *(const LAS f32x4*)(BcL + t * 256 + c), b1 = *(const LAS f32x4*)(BcL + t * 256 + c + 4);
                  const f32x4 t00 = *(const LAS f32x4*)(tot + c), t01 = *(const LAS f32x4*)(tot + c + 4), t10 = *(const LAS f32x4*)(tot + 256 + c), t11 = *(const LAS f32x4*)(tot + 256 + c + 4);
#pragma unroll
                  for (int e = 0; e < 4; ++e) { bt[e] = b0[e] + (t >= 32 ? t00[e] : 0.f); bt[4 + e] = b1[e] + (t >= 32 ? t01[e] : 0.f); be[e] = t00[e] + t10[e]; be[4 + e] = t01[e] + t11[e]; } }
                u32x4 oqi, oqa, oke;
#pragma unroll
                for (int e = 0; e < 4; ++e) {
                    const float q0 = bf2f(qv[e] & 0xffffu), q1 = bf2f(qv[e] >> 16), k0 = bf2f(kv[e] & 0xffffu), k1 = bf2f(kv[e] >> 16);
                    const float e0 = __expf(bt[2 * e]), e1 = __expf(bt[2 * e + 1]), d0 = __expf(bt[2 * e] - be[2 * e]), d1 = __expf(bt[2 * e + 1] - be[2 * e + 1]);
                    oqi[e] = pk2(q0 * e0, q1 * e1); oqa[e] = pk2(q0 * d0, q1 * d1); oke[e] = pk2(k0 / d0, k1 / d1);
                }
                *(u32x4*)(Qi + t * 256 + c) = oqi;
                *(LAS u32x4*)(QaL + t * 264 + c) = oqa; *(LAS u32x4*)(KeL + t * 264 + c) = oke;
            }
            if (tid < 256) dec[tid] = __expf(tot[tid] + tot[256 + tid]);
        }
        u32x4 vr0[4], vr1[4];
#pragma unroll
        for (int itr = 0; itr < 4; ++itr) { const int sp = itr * 8 + (lane >> 3), vc = wave * 8 + (lane & 7);
            vr0[itr] = *(const u32x4*)(P + (size_t)(2 * sp) * NIN + 2048 + h * 512 + vc * 8); vr1[itr] = *(const u32x4*)(P + (size_t)(2 * sp + 1) * NIN + 2048 + h * 512 + vc * 8); }
        __syncthreads();
        {
            const int mt = wave >> 1, ns0 = 2 * (wave & 1), lr = lane & 15, g = lane >> 4;
            f32x4 pacc[2] = {(f32x4){0.f, 0.f, 0.f, 0.f}, (f32x4){0.f, 0.f, 0.f, 0.f}};
#pragma unroll
            for (int st = 0; st < 8; ++st) {
                const bf16x8 av = *(const LAS bf16x8*)(QaL + (mt * 16 + lr) * 264 + 32 * st + 8 * g);
#pragma unroll
                for (int j = 0; j < 2; ++j) { const bf16x8 bv = *(const LAS bf16x8*)(KeL + ((ns0 + j) * 16 + lr) * 264 + 32 * st + 8 * g);
                    pacc[j] = __builtin_amdgcn_mfma_f32_16x16x32_bf16(av, bv, pacc[j], 0, 0, 0); }
            }
#pragma unroll
            for (int j = 0; j < 2; ++j)
#pragma unroll
                for (int i = 0; i < 4; ++i) { const int t = mt * 16 + 4 * g + i, s = (ns0 + j) * 16 + lr; Pg[t * 64 + s] = (bf16_t)f2bf(s <= t ? pacc[j][i] : 0.f); }
        }
        __syncthreads();
        {
            const int c = tid & 255, half = tid >> 8;
#pragma unroll 1
            for (int j = 0; j < 4; ++j) {
                unsigned w[4];
#pragma unroll
                for (int e = 0; e < 4; ++e) w[e] = (unsigned)KeL[(half * 32 + 8 * j + 2 * e) * 264 + c] | ((unsigned)KeL[(half * 32 + 8 * j + 2 * e + 1) * 264 + c] << 16);
                *(LAS u32x4*)(KeTL + c * 72 + half * 32 + j * 8) = (u32x4){w[0], w[1], w[2], w[3]};
            }
        }
        __syncthreads();
        {
            const int vc = wave * 8 + (lane & 7), sp0 = lane >> 3;
#pragma unroll
            for (int itr = 0; itr < 4; ++itr) {
                const int sp = itr * 8 + sp0;
                const u32x4 r0 = vr0[itr], r1 = vr1[itr];
#pragma unroll
                for (int e = 0; e < 4; ++e) { VTLw[(vc * 8 + 2 * e) * 36 + sp] = (r0[e] & 0xffffu) | (r1[e] << 16); VTLw[(vc * 8 + 2 * e + 1) * 36 + sp] = (r0[e] >> 16) | (r1[e] & 0xffff0000u); }
            }
        }
        __syncthreads();
        {
#pragma unroll
            for (int jj = 0; jj < 8; ++jj) { const int p = tid + 512 * jj, v = p >> 3, cc = p & 7; *(u32x4*)(VT + v * 64 + cc * 8) = *(const LAS u32x4*)(VTL + v * 72 + cc * 8); }
            bf16_t* KeTg = (bf16_t*)(gp + GP_KET);
#pragma unroll
            for (int jj = 0; jj < 4; ++jj) { const int p = tid + 512 * jj; *(u32x4*)(KeTg + (size_t)p * 8) = *(const LAS u32x4*)(KeTL + (p >> 3) * 72 + (p & 7) * 8); }
        }
    }
}

__device__ __forceinline__ void gla_x2_chain(CArgs* a, LAS unsigned char* lds, int item0, int nsteps, int vs, const float* sinit, float* sout) {
    const int tid = opq_tid(), lane = tid & 63, wave = __builtin_amdgcn_readfirstlane(tid >> 6), lr = lane & 15, g = lane >> 4;
    constexpr int BUF = 42496;
    f32x4 S[2][2];
#pragma unroll
    for (int kl = 0; kl < 2; ++kl)
#pragma unroll
        for (int vt = 0; vt < 2; ++vt)
#pragma unroll
            for (int i = 0; i < 4; ++i) S[kl][vt][i] = sinit ? sinit[(size_t)(16 * (2 * wave + kl) + 4 * g + i) * 512 + 32 * vs + 16 * vt + lr] : 0.f;
    u32x4 kregA[4], xregA, kregB[4], xregB;
#define X2_LOAD(KR, XR, c_) do { const unsigned char* gp_ = a->ws + WS_GPRE + (size_t)(item0 + (c_)) * GPRE_ITEM; \
        _Pragma("unroll") for (int j = 0; j < 4; ++j) KR[j] = *(const u32x4*)(gp_ + GP_KET + (size_t)(tid + 512 * j) * 16); \
        if (tid < 256) XR = *(const u32x4*)(gp_ + GP_VT + (size_t)(32 * vs) * 128 + (size_t)tid * 16); \
        else if (tid < 320) XR = *(const u32x4*)(gp_ + GP_DEC + (size_t)(tid - 256) * 16); } while (0)
#define X2_STAGE(KR, XR, b_) do { LAS unsigned char* bb_ = lds + (b_) * BUF; \
        _Pragma("unroll") for (int j = 0; j < 4; ++j) { const int p = tid + 512 * j; *(LAS u32x4*)(bb_ + ((p >> 3) * 72 + (p & 7) * 8) * 2) = KR[j]; } \
        if (tid < 256) *(LAS u32x4*)(bb_ + 36864 + ((tid >> 3) * 72 + (tid & 7) * 8) * 2) = XR; \
        else if (tid < 320) *(LAS u32x4*)(bb_ + 41472 + (tid - 256) * 16) = XR; } while (0)
#define X2_COMPUTE(c_) do { \
            LAS unsigned char* bb = lds + ((c_) % 3) * BUF; \
            const LAS bf16_t* KeTL = (const LAS bf16_t*)bb; const LAS bf16_t* VTL = (const LAS bf16_t*)(bb + 36864); const LAS float* decL = (const LAS float*)(bb + 41472); \
            bf16_t* stp = (bf16_t*)(a->ws + WS_UST) + (size_t)(item0 + (c_)) * 131072 + (size_t)(32 * vs + lr) * 256 + 4 * g; \
            bf16x8 vb[2][2]; \
            _Pragma("unroll") for (int vt = 0; vt < 2; ++vt) _Pragma("unroll") for (int st = 0; st < 2; ++st) vb[vt][st] = *(const LAS bf16x8*)(VTL + (16 * vt + lr) * 72 + 32 * st + 8 * g); \
            _Pragma("unroll") for (int kl = 0; kl < 2; ++kl) { const int kt = 2 * wave + kl; \
                const f32x4 d = *(const LAS f32x4*)(decL + 16 * kt + 4 * g); \
                const bf16x8 a0 = *(const LAS bf16x8*)(KeTL + (kt * 16 + lr) * 72 + 8 * g), a1 = *(const LAS bf16x8*)(KeTL + (kt * 16 + lr) * 72 + 32 + 8 * g); \
                _Pragma("unroll") for (int vt = 0; vt < 2; ++vt) { \
                    u32x2 w; w.x = pk2(S[kl][vt][0], S[kl][vt][1]); w.y = pk2(S[kl][vt][2], S[kl][vt][3]); *(u32x2*)(stp + (size_t)vt * 16 * 256 + 16 * kt) = w; \
                    S[kl][vt] = S[kl][vt] * d; \
                    S[kl][vt] = __builtin_amdgcn_mfma_f32_16x16x32_bf16(a0, vb[vt][0], S[kl][vt], 0, 0, 0); \
                    S[kl][vt] = __builtin_amdgcn_mfma_f32_16x16x32_bf16(a1, vb[vt][1], S[kl][vt], 0, 0, 0); } } } while (0)
    __syncthreads();
    X2_LOAD(kregA, xregA, 0);
    if (nsteps > 1) X2_LOAD(kregB, xregB, 1);
    X2_STAGE(kregA, xregA, 0);
    __syncthreads();
    for (int c = 0; c < nsteps; c += 2) {
        if (c + 2 < nsteps) X2_LOAD(kregA, xregA, c + 2);
        X2_COMPUTE(c);
        if (c + 1 < nsteps) X2_STAGE(kregB, xregB, (c + 1) % 3);
        LDS_BARRIER();
        if (c + 1 >= nsteps) break;
        if (c + 3 < nsteps) X2_LOAD(kregB, xregB, c + 3);
        X2_COMPUTE(c + 1);
        if (c + 2 < nsteps) X2_STAGE(kregA, xregA, (c + 2) % 3);
        LDS_BARRIER();
    }
#undef X2_LOAD
#undef X2_STAGE
#undef X2_COMPUTE
#pragma unroll
    for (int kl = 0; kl < 2; ++kl)
#pragma unroll
        for (int vt = 0; vt < 2; ++vt)
#pragma unroll
            for (int i = 0; i < 4; ++i) sout[(size_t)(16 * (2 * wave + kl) + 4 * g + i) * 512 + 32 * vs + 16 * vt + lr] = S[kl][vt][i];
}
__device__ __forceinline__ void gla_x2(CArgs* a, LAS unsigned char* lds, int vcu, int G, int l) {
    for (int jb = vcu; jb < 256 + 1024; jb += G) {
        const bool pr = jb < 256; const int si = pr ? jb : jb - 256, s = si >> 4, vs = si & 15, b = s >> 2, h = s & 3;
        const float* sinit = pr ? nullptr : a->in[2] + ((size_t)(l * 16 + b) * 4 + h) * 131072;
        float* sout = pr ? a->out + OUT_GLAP + ((size_t)(l * 4 + b) * 4 + h) * 131072 : a->out + OUT_GLAS + ((size_t)(l * 16 + b) * 4 + h) * 131072;
        gla_x2_chain(a, lds, pr ? s * 64 : 1024 + s, pr ? 64 : 1, vs, sinit, sout);
    }
}

__device__ __forceinline__ void gla_x3(CArgs* a, LAS unsigned char* lds, int vcu, int G, int l) {
    const int tid = opq_tid(), lane = tid & 63, wave = __builtin_amdgcn_readfirstlane(tid >> 6), lr = lane & 15, g = lane >> 4;
    LAS bf16_t* QiL = (LAS bf16_t*)lds;
    LAS bf16_t* PL = (LAS bf16_t*)(lds + 33792);
    LAS float* red = (LAS float*)(lds + 43008);
    LAS float* rsL = (LAS float*)(lds + 45056);
    const bf16_t* PROJ = (const bf16_t*)(a->ws + WS_PROJ); bf16_t* OG = (bf16_t*)(a->ws + WS_OG);
    const float* hn = a->in[10] + (size_t)l * 512;
    for (int it = vcu; it < 1088; it += G) {
        int row0, h;
        if (it < 1024) { const int s = it >> 6, c = it & 63; h = s & 3; row0 = (s >> 2) * 4096 + c * 64; }
        else { const int s = it - 1024; h = s & 3; row0 = MP + (s >> 2) * 64; }
        const unsigned char* gp = a->ws + WS_GPRE + (size_t)it * GPRE_ITEM;
        const bf16_t* Qi = (const bf16_t*)(gp + GP_QI); const bf16_t* Pg = (const bf16_t*)(gp + GP_P); const bf16_t* VT = (const bf16_t*)(gp + GP_VT);
        const bf16_t* ST = (const bf16_t*)(a->ws + WS_UST) + (size_t)it * 131072;
        __syncthreads();
#pragma unroll
        for (int j = 0; j < 4; ++j) { const int p = tid + 512 * j; *(LAS u32x4*)(QiL + (p >> 5) * 264 + (p & 31) * 8) = *(const u32x4*)(Qi + (size_t)p * 8); }
        *(LAS u32x4*)(PL + (tid >> 3) * 72 + (tid & 7) * 8) = *(const u32x4*)(Pg + (size_t)tid * 8);
        const bf16_t* vtp = VT + (size_t)(64 * wave + lr) * 64 + 8 * g; const bf16_t* stp = ST + (size_t)(64 * wave + lr) * 256 + 8 * g;
#define X3_A(st, mt) ((st) < 2 ? *(const bf16x8*)(vtp + (size_t)(mt) * 16 * 64 + 32 * (st)) : *(const bf16x8*)(stp + (size_t)(mt) * 16 * 256 + 32 * ((st) - 2)))
#define X3_B(st, nt) ((st) < 2 ? *(const LAS bf16x8*)(PL + (16 * (nt) + lr) * 72 + 32 * (st) + 8 * g) : *(const LAS bf16x8*)(QiL + (16 * (nt) + lr) * 264 + 32 * ((st) - 2) + 8 * g))
        bf16x8 A0[4][4], A1[3][4];
#pragma unroll
        for (int s_ = 0; s_ < 4; ++s_)
#pragma unroll
            for (int mt = 0; mt < 4; ++mt) A0[s_][mt] = X3_A(s_, mt);
#pragma unroll
        for (int s_ = 0; s_ < 3; ++s_)
#pragma unroll
            for (int mt = 0; mt < 4; ++mt) A1[s_][mt] = X3_A(4 + s_, mt);
        __syncthreads();
        f32x4 o[4][4];
#pragma unroll
        for (int mt = 0; mt < 4; ++mt)
#pragma unroll
            for (int nt = 0; nt < 4; ++nt) o[mt][nt] = (f32x4){0.f, 0.f, 0.f, 0.f};
#pragma unroll
        for (int s_ = 0; s_ < 4; ++s_) { bf16x8 bf[4];
#pragma unroll
            for (int nt = 0; nt < 4; ++nt) bf[nt] = X3_B(s_, nt);
#pragma unroll
            for (int mt = 0; mt < 4; ++mt)
#pragma unroll
                for (int nt = 0; nt < 4; ++nt) o[mt][nt] = __builtin_amdgcn_mfma_f32_16x16x32_bf16(A0[s_][mt], bf[nt], o[mt][nt], 0, 0, 0); }
#pragma unroll
        for (int s_ = 0; s_ < 3; ++s_)
#pragma unroll
            for (int mt = 0; mt < 4; ++mt) A0[s_][mt] = X3_A(7 + s_, mt);
#pragma unroll
        for (int s_ = 0; s_ < 3; ++s_) { bf16x8 bf[4];
#pragma unroll
            for (int nt = 0; nt < 4; ++nt) bf[nt] = X3_B(4 + s_, nt);
#pragma unroll
            for (int mt = 0; mt < 4; ++mt)
#pragma unroll
                for (int nt = 0; nt < 4; ++nt) o[mt][nt] = __builtin_amdgcn_mfma_f32_16x16x32_bf16(A1[s_][mt], bf[nt], o[mt][nt], 0, 0, 0); }
#pragma unroll
        for (int s_ = 0; s_ < 3; ++s_) { bf16x8 bf[4];
#pragma unroll
            for (int nt = 0; nt < 4; ++nt) bf[nt] = X3_B(7 + s_, nt);
#pragma unroll
            for (int mt = 0; mt < 4; ++mt)
#pragma unroll
                for (int nt = 0; nt < 4; ++nt) o[mt][nt] = __builtin_amdgcn_mfma_f32_16x16x32_bf16(A0[s_][mt], bf[nt], o[mt][nt], 0, 0, 0); }
#undef X3_A
#undef X3_B
#pragma unroll
        for (int nt = 0; nt < 4; ++nt) { float s = 0.f;
#pragma unroll
            for (int mt = 0; mt < 4; ++mt)
#pragma unroll
                for (int i = 0; i < 4; ++i) s += o[mt][nt][i] * o[mt][nt][i];
            s += __shfl_xor(s, 16); s += __shfl_xor(s, 32);
            if (g == 0) red[wave * 64 + 16 * nt + lr] = s; }
        __syncthreads();
        if (tid < 64) { float s = 0.f;
#pragma unroll
            for (int w = 0; w < 8; ++w) s += red[w * 64 + tid];
            rsL[tid] = rsqrtf(s * (1.f / 512.f) + EPS); }
        __syncthreads();
#pragma unroll
        for (int nt = 0; nt < 4; ++nt) {
            const int t = 16 * nt + lr; const float rs = rsL[t];
#pragma unroll
            for (int mt = 0; mt < 4; ++mt) {
                const int vv = 64 * wave + 16 * mt + 4 * g;
                const u32x2 rv = *(const u32x2*)(PROJ + (size_t)(row0 + t) * NIN + 4096 + h * 512 + vv);
                const f32x4 gn = *(const f32x4*)(hn + vv);
                const float r0 = bf2f(rv.x & 0xffffu), r1 = bf2f(rv.x >> 16), r2 = bf2f(rv.y & 0xffffu), r3 = bf2f(rv.y >> 16);
                u32x2 w; w.x = pk2(o[mt][nt][0] * rs * gn[0] * silu_f(r0), o[mt][nt][1] * rs * gn[1] * silu_f(r1)); w.y = pk2(o[mt][nt][2] * rs * gn[2] * silu_f(r2), o[mt][nt][3] * rs * gn[3] * silu_f(r3));
                *(u32x2*)(OG + (size_t)(row0 + t) * DM + h * 512 + vv) = w;
            }
        }
    }
}

__device__ __forceinline__ void attn_phase(CArgs* a, LAS unsigned char* lds, int vcu, int G, int j  ) {
    const int tid = opq_tid(), lane = tid & 63, wave = __builtin_amdgcn_readfirstlane(tid >> 6), l32 = lane & 31, hf = lane >> 5;
    LAS bf16_t* KL = (LAS bf16_t*)lds;
    LAS unsigned* VTLw = (LAS unsigned*)(lds + 17408);
    LAS float* RB = (LAS float*)(lds + 35840);
    const bf16_t* Q = (const bf16_t*)(a->ws + WS_Q); bf16_t* OA = (bf16_t*)(a->ws + WS_OG);
    const bf16_t* KVP = (const bf16_t*)(a->ws + WS_KVP); const bf16_t* KVS = (const bf16_t*)(a->ws + WS_KVS);
    const int gq = wave >> 1, tq = 32 * (wave & 1) + l32;
    __syncthreads();
    for (int i = tid; i < 16 * 513; i += 512) RB[i] = a->in[15][(size_t)j * 16 * 513 + i] * 1.4426950408889634f;
    const bool deal = (G == 256);
    const int nmine = deal ? (vcu < 64 ? 5 : 4) : (1088 - vcu + G - 1) / G;
    for (int ii = 0; ii < nmine; ++ii) {
        int it;
        if (!deal) it = vcu + ii * G;
        else {
            int f = -1, sb = 0, sc = 0, sn = 0;
            if (vcu < 64) { if (ii < 3) f = vcu * 3 + ii; else { const int t = vcu & 3, bn = vcu >> 2; sb = bn >> 2; sn = bn & 3; sc = (ii == 3) ? t : 7 - t; } }
            else f = 192 + (vcu - 64) * 4 + ii;
            if (f < 0) it = sb * 256 + sc * 4 + sn;
            else if (f < 896) { const int b = f / 224, rem = f % 224; it = b * 256 + (8 + (rem >> 2)) * 4 + (rem & 3); }
            else it = 1024 + (f - 896);
        }
        int qrow0, n, ntile; const bf16_t* kvb;
        if (it < 1024) { const int b = it >> 8, c = (it >> 2) & 63; n = it & 3; qrow0 = b * 4096 + c * 64; ntile = (c < 8 ? c : 8) + 1; kvb = KVP + (size_t)(b * 4096 + (c - (ntile - 1)) * 64) * 1024; }
        else { const int s = it - 1024, b = s >> 2; n = s & 3; qrow0 = MP + b * 64; ntile = 9; kvb = KVS + (size_t)b * 576 * 1024; }
        const int hq = n * 4 + gq;
        __syncthreads();
        bf16x8 qf[8];
#pragma unroll
        for (int st = 0; st < 8; ++st) qf[st] = *(const bf16x8*)(Q + (size_t)(qrow0 + tq) * DM + hq * 128 + 16 * st + 8 * hf);
        float mrun = -1e30f, lrun = 0.f;
        f32x16 oacc[4];
#pragma unroll
        for (int dt = 0; dt < 4; ++dt)
#pragma unroll
            for (int i = 0; i < 16; ++i) oacc[dt][i] = 0.f;
        const int pcc = tid & 15, psp = tid >> 4;
        u32x4 kp0, kp1, vp0, vp1;
        { const bf16_t* kt = kvb + n * 128 + (size_t)(2 * psp) * 1024 + pcc * 8; kp0 = *(const u32x4*)kt; kp1 = *(const u32x4*)(kt + 1024); vp0 = *(const u32x4*)(kt + 512); vp1 = *(const u32x4*)(kt + 1536); }
        for (int tl = 0; tl < ntile; ++tl) {
            const int d = ntile - 1 - tl;
            LDS_BARRIER();
            *(LAS u32x4*)(KL + (2 * psp) * 136 + pcc * 8) = kp0; *(LAS u32x4*)(KL + (2 * psp + 1) * 136 + pcc * 8) = kp1;
#pragma unroll
            for (int e = 0; e < 4; ++e) { VTLw[(pcc * 8 + 2 * e) * 36 + (psp ^ (2 * pcc))] = (vp0[e] & 0xffffu) | (vp1[e] << 16); VTLw[(pcc * 8 + 2 * e + 1) * 36 + (psp ^ (2 * pcc))] = (vp0[e] >> 16) | (vp1[e] & 0xffff0000u); }
            if (tl + 1 < ntile) { const bf16_t* kt = kvb + (size_t)(tl + 1) * 64 * 1024 + n * 128 + (size_t)(2 * psp) * 1024 + pcc * 8; kp0 = *(const u32x4*)kt; kp1 = *(const u32x4*)(kt + 1024); vp0 = *(const u32x4*)(kt + 512); vp1 = *(const u32x4*)(kt + 1536); }
            LDS_BARRIER();
            f32x16 sacc[2];
#pragma unroll
            for (int ms = 0; ms < 2; ++ms) {
#pragma unroll
                for (int i = 0; i < 16; ++i) sacc[ms][i] = 0.f;
#pragma unroll
                for (int st = 0; st < 8; ++st) { const bf16x8 av = *(const LAS bf16x8*)(KL + (32 * ms + l32) * 136 + 16 * st + 8 * hf); sacc[ms] = __builtin_amdgcn_mfma_f32_32x32x16_bf16(av, qf[st], sacc[ms], 0, 0, 0); }
            }
            if (d >= 5) { const float bc = RB[hq * 513 + 512];
#pragma unroll
                for (int ms = 0; ms < 2; ++ms)
#pragma unroll
                    for (int i = 0; i < 16; ++i) sacc[ms][i] += bc; }
            else {
#pragma unroll
                for (int ms = 0; ms < 2; ++ms)
#pragma unroll
                    for (int i = 0; i < 16; ++i) { const int s = 32 * ms + 8 * (i >> 2) + 4 * hf + (i & 3); int rel = 64 * d + tq - s; rel = rel > 256 ? 256 : rel; sacc[ms][i] += RB[hq * 513 + rel + 256]; }
            }
            float mx = sacc[0][0];
#pragma unroll
            for (int ms = 0; ms < 2; ++ms)
#pragma unroll
                for (int i = 0; i < 16; ++i) mx = fmaxf(mx, sacc[ms][i]);
            mx = fmaxf(mx, __shfl_xor(mx, 32));
            const float mnew = fmaxf(mrun, mx), alpha = __builtin_amdgcn_exp2f(mrun - mnew);
            float ls = 0.f;
#pragma unroll
            for (int ms = 0; ms < 2; ++ms)
#pragma unroll
                for (int i = 0; i < 16; ++i) { const float p = __builtin_amdgcn_exp2f(sacc[ms][i] - mnew); sacc[ms][i] = p; ls += p; }
            ls += __shfl_xor(ls, 32);
            lrun = lrun * alpha + ls; mrun = mnew;
            if (__any(alpha != 1.f)) {
#pragma unroll
                for (int dt = 0; dt < 4; ++dt)
#pragma unroll
                    for (int i = 0; i < 16; ++i) oacc[dt][i] *= alpha;
            }
#pragma unroll
            for (int st2 = 0; st2 < 4; ++st2) {
                const int ms = st2 >> 1, i0 = 8 * (st2 & 1);
                u32x4 pw; pw.x = pk2_sw(sacc[ms][i0], sacc[ms][i0 + 1]); pw.y = pk2_sw(sacc[ms][i0 + 2], sacc[ms][i0 + 3]); pw.z = pk2_sw(sacc[ms][i0 + 4], sacc[ms][i0 + 5]); pw.w = pk2_sw(sacc[ms][i0 + 6], sacc[ms][i0 + 7]);
                const bf16x8 pb = __builtin_bit_cast(bf16x8, pw);
#pragma unroll
                for (int dt = 0; dt < 4; ++dt) {
                    const int dd = 32 * dt + l32, sw = 2 * ((dd >> 3) & 15);
                    const u32x2 lo = *(const LAS u32x2*)(VTLw + dd * 36 + ((8 * st2 + 2 * hf) ^ sw)), hi = *(const LAS u32x2*)(VTLw + dd * 36 + ((8 * st2 + 2 * hf + 4) ^ sw));
                    const bf16x8 av = __builtin_bit_cast(bf16x8, (u32x4){lo.x, lo.y, hi.x, hi.y});
                    oacc[dt] = __builtin_amdgcn_mfma_f32_32x32x16_bf16(av, pb, oacc[dt], 0, 0, 0);
                }
            }
        }
        const float inv = 1.f / lrun;
        bf16_t* orow = OA + (size_t)(qrow0 + tq) * DM + hq * 128;
#pragma unroll
        for (int dt = 0; dt < 4; ++dt)
#pragma unroll
            for (int i4 = 0; i4 < 4; ++i4) { u32x2 w; w.x = pk2(oacc[dt][4 * i4] * inv, oacc[dt][4 * i4 + 1] * inv); w.y = pk2(oacc[dt][4 * i4 + 2] * inv, oacc[dt][4 * i4 + 3] * inv);
                *(u32x2*)(orow + 32 * dt + 8 * i4 + 4 * hf) = w; }
    }
}

__global__ void __launch_bounds__(512) yoco_fwd(Args a_unused) {
    extern __shared__ __attribute__((aligned(16))) unsigned char lds_raw[];
    LAS unsigned char* lds = (LAS unsigned char*)lds_raw;
    cg::grid_group grid = cg::this_grid();
    const int G = gridDim.x, bx = blockIdx.x;
    const int vcu = (G % 8 == 0) ? (bx % 8) * (G / 8) + bx / 8 : bx;
    const int lo = get_args()->ph_lo, hi = get_args()->ph_hi;
    int ph = 0;
    if (threadIdx.x < 16) ((LAS unsigned*)(lds + LDS_BARST))[threadIdx.x] = 0u;
    __syncthreads();
    XcdBarrier bar = xcd_barrier_post((unsigned*)(get_args()->ws + WS_CTL), (volatile LAS unsigned*)(lds + LDS_BARST));
#define RUN (ph >= lo && ph < hi)
#ifndef R_SYNC
#define R_SYNC 1
#endif
#ifndef R_P0
#define R_P0 1
#endif
#ifndef R_PRE
#define R_PRE 1
#endif
#ifndef R_X3
#define R_X3 1
#endif
#ifndef R_X2
#define R_X2 1
#endif
#ifndef R_ATT
#define R_ATT 1
#endif
#ifndef R_CONV
#define R_CONV 1
#endif
#define GSYNC() do { if (lo < 0) grid.sync(); else xcd_barrier(bar); } while (0)
#define SEAM() do { ++ph; if (ph > lo && ph < hi) { for (int r_ = 0; r_ < R_SYNC; ++r_) GSYNC(); } } while (0)
#ifndef R_GEMM
#define R_GEMM 1
#endif
#define REP(n, call) do { for (int q_ = 0; q_ < (n); ++q_) { call; if (q_ + 1 < (n)) xcd_barrier(bar); } } while (0)

    if (RUN) REP(R_P0, p0_prologue(get_args(), lds, vcu, G));
    SEAM();
#pragma unroll 1
    for (int l = 0; l < 4; ++l) {
        if (RUN) {
            CArgs* a = get_args(); unsigned char* ws = a->ws; const bf16_t* H = (const bf16_t*)(ws + WS_XB);
            pg8::Gemm g; pg8::EpiGen E{};
            if (l < 2) { g = pg8::Gemm{H, (const bf16_t*)(ws + WS_WIN) + (size_t)l * NIN * 2048, M, NIN, 2048}; E.O = (bf16_t*)(ws + WS_PROJ); E.ldc = NIN; E.kvq = 0; }
            else if (l == 2) { g = pg8::Gemm{H, (const bf16_t*)(ws + WS_WKVQ), M, 3072, 2048}; E.O = (bf16_t*)(ws + WS_Q); E.ldc = DM; E.kvq = 1; }
            else { g = pg8::Gemm{H, (const bf16_t*)(ws + WS_WQ3), M, 2048, 2048}; E.O = (bf16_t*)(ws + WS_Q); E.ldc = DM; E.kvq = 0; }
            if (l == 2) kvs_cache_convert(a, vcu, G);
            E.rs = (const float*)(ws + WS_RS); E.KVP = (bf16_t*)(ws + WS_KVP); E.KVS = (bf16_t*)(ws + WS_KVS); E.okp = a->out + OUT_KP; E.ovp = a->out + OUT_VP; E.oks = a->out + OUT_KS; E.ovs = a->out + OUT_VS;
            pg8::StaticOrder S; S.init(g.M, g.N, G, bx);
            REP(R_GEMM, (pg8::gemm_phase<pg8::EpiGen, pg8::StaticOrder, true, true>(lds, g, S, E)));
            if (l == 0) convert_in_phase(a, lds, G, bx, l, 164, 0, 0, 0, 3072, 12544); else if (l == 1) convert_in_phase(a, lds, G, bx, l, 164, 0, 348); else if (l == 2) convert_in_phase(a, lds, G, bx, l, 48, 0, 553);
        }
        SEAM();
        if (l < 2) {
            if (RUN) REP(R_PRE, gla_pre(get_args(), lds, vcu, G, l));
            SEAM();
            if (RUN) REP(R_X2, gla_x2(get_args(), lds, vcu, G, l));
            SEAM();
            if (RUN) REP(R_X3, gla_x3(get_args(), lds, vcu, G, l));
            SEAM();
        } else {
            if (RUN) REP(R_ATT, attn_phase(get_args(), lds, vcu, G, l - 2));
            SEAM();
        }
        if (RUN) {
            unsigned char* ws = get_args()->ws; bf16_t* MF = (bf16_t*)(ws + WS_MF);
            const bf16_t* W = l < 2 ? (const bf16_t*)(ws + WS_GWO) + (size_t)l * 2048 * 2048 : (const bf16_t*)(ws + WS_AWO) + (size_t)(l - 2) * 2048 * 2048;
            pg8::Gemm g{(const bf16_t*)(ws + WS_OG), W, M, 2048, 2048}; pg8::EpiF32 E{MF, DM, (float*)(ws + WS_MFP), MP, (size_t)MS * DM};
            pg8::TailSplitOrder S; S.init(MP / 256, MS / 256, 2048, 8, 2048, G, bx);
            REP(R_GEMM, (pg8::gemm_phase<pg8::EpiF32, pg8::TailSplitOrder, true, true>(lds, g, S, E)));
        }
        SEAM();
        if (RUN) norm_pass(get_args(), lds, vcu, G, get_args()->in[6] + (l * 4 + 1) * 2048, false, true, 8);
        SEAM();
        if (RUN) {
            unsigned char* ws = get_args()->ws; const bf16_t* H = (const bf16_t*)(ws + WS_XB);
            CArgs* a = get_args();
            pg8::Gemm g{H, (const bf16_t*)(ws + WS_WUP) + (size_t)l * NUP * 2048, M, NUP, 2048};
            pg8::EpiUp E{(bf16_t*)(ws + WS_HF), a->in[18] + (size_t)l * 3 * DFF, a->in[19] + (size_t)l * DFF, (float*)(ws + WS_GT), (float*)(ws + WS_GH), (float*)(ws + WS_VH), (const float*)(ws + WS_RS)};
            pg8::StaticOrder S; S.init(g.M, g.N, G, bx);
            REP(R_GEMM, (pg8::gemm_phase<pg8::EpiUp, pg8::StaticOrder, true, true>(lds, g, S, E)));
            if (l == 0) convert_in_phase(a, lds, G, bx, l, 176, 0, 450); else if (l == 1) convert_in_phase(a, lds, G, bx, l, 176, 348, 649); else convert_in_phase(a, lds, G, bx, l, 176, 553, 764);
        }
        SEAM();
        if (RUN) REP(R_CONV, conv_pass(get_args(), vcu, G, l));
        SEAM();
        if (RUN) {
            unsigned char* ws = get_args()->ws; bf16_t* MF = (bf16_t*)(ws + WS_MF);
            pg8::Gemm g{(const bf16_t*)(ws + WS_HF), (const bf16_t*)(ws + WS_WDN) + (size_t)l * 2048 * DFF, M, 2048, DFF}; pg8::EpiF32 E{MF, DM, (float*)(ws + WS_MFP), MP, (size_t)MS * DM};
            pg8::TailSplitOrder S; S.init(MP / 256, MS / 256, 2048, 4, DFF, G, bx);
            REP(R_GEMM, (pg8::gemm_phase<pg8::EpiF32, pg8::TailSplitOrder, true, true>(lds, g, S, E)));
            if (l == 0) convert_in_phase(get_args(), lds, G, bx, l, 128, 450, 1024); else if (l == 1) convert_in_phase(get_args(), lds, G, bx, l, 128, 649, 1024); else convert_in_phase(get_args(), lds, G, bx, l, 128, 764, 1024);
        }
        SEAM();
        if (RUN) norm_pass(get_args(), lds, vcu, G, get_args()->in[6] + (l * 4 + 3) * 2048, false, l < 3, 4);
        SEAM();
    }
#undef RUN
#undef SEAM
}

extern "C" void kernel_launch(void* const* d_in, const int* in_sizes, int n_in, void* d_out, int out_size, void* d_ws, size_t ws_size, hipStream_t stream) {
    static int grid = 0;
    if (grid == 0) {
        if (n_in != 21 || ws_size < WS_END6) { fprintf(stderr, "kernel_launch: unexpected n_in %d / ws_size %zu (need %zu)\n", n_in, ws_size, (size_t)WS_END6); grid = -1; return; }
        int dev = 0, cus = 0, per_cu = 0;
        hipGetDevice(&dev); hipDeviceGetAttribute(&cus, hipDeviceAttributeMultiprocessorCount, dev);
        hipFuncSetAttribute((const void*)yoco_fwd, hipFuncAttributeMaxDynamicSharedMemorySize, LDS_BYTES);
        hipOccupancyMaxActiveBlocksPerMultiprocessor(&per_cu, (const void*)yoco_fwd, 512, LDS_BYTES);
        if (per_cu < 1) { fprintf(stderr, "kernel_launch: occupancy query says %d blocks per CU\n", per_cu); per_cu = 1; }
        (void)hipGetLastError();
        grid = cus * per_cu;
    }
    if (grid < 0) return;
    if (hipMemsetAsync((char*)d_ws + WS_CTL, 0, CTL_BYTES, stream) != hipSuccess) { fprintf(stderr, "memset failed\n"); return; }
    Args a{};
    for (int i = 0; i < 21; ++i) a.in[i] = (const float*)d_in[i];
    a.out = (float*)d_out; a.ws = (unsigned char*)d_ws; a.ph_lo = 0; a.ph_hi = 1000;
    void* args[] = {&a};
    hipError_t e = hipLaunchCooperativeKernel((const void*)yoco_fwd, dim3(grid), dim3(512), args, LDS_BYTES, stream);
    if (e != hipSuccess) fprintf(stderr, "cooperative launch failed: %s (grid %d)\n", hipGetErrorString(e), grid);
}
```

```cpp
#include <hip/hip_runtime.h>
#include <hip/hip_cooperative_groups.h>
#include <cstdio>
#include <cstdint>
#define LAS __attribute__((address_space(3)))
__device__ __forceinline__ int opq_tid() { int t = threadIdx.x; asm volatile("" : "+v"(t)); return t; }
namespace pg8 {
#define PG8_LAS __attribute__((address_space(3)))
typedef unsigned short bf16_t;
typedef short bf16x8 __attribute__((ext_vector_type(8)));
typedef float f32x4 __attribute__((ext_vector_type(4)));
typedef unsigned u32x4 __attribute__((ext_vector_type(4)));
constexpr int BM = 256, BK = 64, HALF = 128, HTB = HALF * BK * 2  , STAGE_BYTES = 8 * HTB, NXCD = 8, WGM = 8;

__host__ __device__ __forceinline__ int lds_byte(int r, int c) { const int st = (r >> 4) * 2 + (c >> 5), rr = r & 15, cc = c & 31, ob = rr * 64 + cc * 2; return st * 1024 + (ob ^ (((ob >> 9) & 1) << 5)); }
__host__ __device__ __forceinline__ void stage_rc(int b, int& R, int& C) { const int st = b / 1024, sb = b % 1024, swz = sb ^ (((sb >> 9) & 1) << 5); R = (st >> 1) * 16 + swz / 64; C = (st & 1) * 32 + (swz % 64) / 2; }
__host__ __device__ __forceinline__ int perm32(int rho) { const int n = rho >> 4, i = rho & 15; return 8 * (i >> 2) + 4 * n + (i & 3); }

struct Unit { int pm, pn, ks, nt; };
struct Gemm { const bf16_t* A; const bf16_t* Bt; int M, N, K; };

struct StaticOrder {
    int nM, nN, nwg, G, c;
    __host__ __device__ void init(int M, int N, int G_, int c_) { nM = M / BM; nN = N / BM; nwg = nM * nN; G = G_; c = c_; }
    __host__ __device__ bool next(int i, Unit& u) const {
        const long L = (long)i * G + c; if (L >= nwg) return false;
        int wgid = (int)L; { const int q = nwg / NXCD, r = nwg % NXCD, xcd = wgid % NXCD, off = wgid / NXCD; wgid = (xcd < r ? xcd * (q + 1) : r * (q + 1) + (xcd - r) * q) + off; }
        const int nig = WGM * nN, gid = wgid / nig, fm = gid * WGM, gsz = (nM - fm) < WGM ? (nM - fm) : WGM;
        u.pm = fm + ((wgid % nig) % gsz); u.pn = (wgid % nig) / gsz; u.ks = 0; u.nt = 0; return true;
    }
    __device__ __forceinline__ void a_ready(const Unit&) const {}
    __device__ __forceinline__ void done(const Unit&) const {}
};
struct TailSplitOrder {
    int nMf, nMt, nN, nfull, S, ntk, G, c;
    __host__ __device__ void init(int nMf_, int nMt_, int N, int S_, int K, int G_, int c_) { nMf = nMf_; nMt = nMt_; nN = N / BM; nfull = nMf * nN; S = S_; ntk = K / BK / S_; G = G_; c = c_; }
    __host__ __device__ bool next(int i, Unit& u) const {
        const long L = (long)i * G + c;
        const bool full = L < nfull;
        const int r = (int)(L - nfull);
        if (!full && r >= nMt * nN * S) return false;
        int wgid = full ? (int)L : 0; { const int q = nfull / NXCD, rr = nfull % NXCD, xcd = wgid % NXCD, off = wgid / NXCD; wgid = (xcd < rr ? xcd * (q + 1) : rr * (q + 1) + (xcd - rr) * q) + off; }
        const int nig = WGM * nN, gid = wgid / nig, fm = gid * WGM, gsz = (nMf - fm) < WGM ? (nMf - fm) : WGM;
        const int fpm = fm + ((wgid % nig) % gsz), fpn = (wgid % nig) / gsz;
        const int rc = full ? 0 : r, tile = rc / S;
        const int pm_ = full ? fpm : nMf + tile % nMt, pn_ = full ? fpn : tile / nMt, ks_ = full ? 0 : rc % S, nt_ = full ? 0 : ntk;
        u.pm = pm_; u.pn = pn_; u.ks = ks_; u.nt = nt_; return true;
    }
    __device__ __forceinline__ void a_ready(const Unit&) const {}
    __device__ __forceinline__ void done(const Unit&) const {}
};
typedef unsigned u32x2v __attribute__((ext_vector_type(2)));
typedef float f32x2c_t __attribute__((ext_vector_type(2))); typedef __bf16 bf16x2c_t __attribute__((ext_vector_type(2)));
__device__ __forceinline__ unsigned cvt_pk_bf16(float lo, float hi) { f32x2c_t v = {lo, hi}; bf16x2c_t b = __builtin_convertvector(v, bf16x2c_t); return __builtin_bit_cast(unsigned, b); }

struct EpiGen {
    static constexpr bool PERM = true, AFTER_DRAIN = false;
    bf16_t* O; int ldc; int kvq; bf16_t* KVP; bf16_t* KVS; float* okp; float* ovp; float* oks; float* ovs; const float* rs;
    int par; PG8_LAS unsigned char* ldsb;
    __device__ __forceinline__ void prefetch(const Unit& u, int p, int wid, int lane, PG8_LAS unsigned char* lds) {
        ldsb = lds;
        if (wid < 4) __builtin_amdgcn_global_load_lds((const unsigned*)(rs + (size_t)u.pm * BM + wid * 64 + lane), (PG8_LAS unsigned*)(lds + 131072 + p * 1024 + wid * 256), 4, 0, 0);
    }
    __device__ __forceinline__ void operator()(const f32x4 (&acc)[2][2][4][2], const Unit& u, int wr, int wc, int fr, int fq) const {
        const int row0 = u.pm * BM + wr * 64 + fr;
        if (!kvq || u.pn >= 4) {
            const int col0 = u.pn * BM - (kvq ? 1024 : 0) + wc * 32 + 8 * fq;
#pragma unroll
            for (int ai = 0; ai < 2; ++ai)
#pragma unroll
                for (int m = 0; m < 4; ++m) { bf16_t* rowp = O + (size_t)(row0 + ai * HALF + m * 16) * ldc + col0; const float rr = ((const PG8_LAS float*)(ldsb + 131072 + par * 1024))[wr * 64 + fr + ai * HALF + m * 16];
#pragma unroll
                    for (int bj = 0; bj < 2; ++bj) { const f32x4 v0 = acc[ai][bj][m][0] * rr, v1 = acc[ai][bj][m][1] * rr;
                        u32x4 w; w.x = cvt_pk_bf16(v0[0], v0[1]); w.y = cvt_pk_bf16(v0[2], v0[3]); w.z = cvt_pk_bf16(v1[0], v1[1]); w.w = cvt_pk_bf16(v1[2], v1[3]);
                        *(u32x4*)(rowp + bj * HALF) = w; } }
        } else {
            const int col0 = u.pn * BM + wc * 32 + 8 * fq;
            const bool isv = col0 >= 512; const int oc = isv ? col0 - 512 : col0;
#pragma unroll
            for (int ai = 0; ai < 2; ++ai)
#pragma unroll
                for (int m = 0; m < 4; ++m) {
                    const int r = row0 + ai * HALF + m * 16; const float rr = ((const PG8_LAS float*)(ldsb + 131072 + par * 1024))[wr * 64 + fr + ai * HALF + m * 16];
                    bf16_t* rowp; float* fo = nullptr;
                    if (r < 16384) { rowp = KVP + (size_t)r * 1024 + col0; const int t = r & 4095;
                        if (t >= 3584) fo = (isv ? ovp : okp) + ((size_t)(r >> 12) * 512 + (t - 3584)) * 512 + oc; }
                    else { const int rs = r - 16384, b = rs >> 6, t = rs & 63; rowp = KVS + ((size_t)b * 576 + 512 + t) * 1024 + col0; fo = (isv ? ovs : oks) + (size_t)rs * 512 + oc; }
#pragma unroll
                    for (int bj = 0; bj < 2; ++bj) { const f32x4 v0 = acc[ai][bj][m][0] * rr, v1 = acc[ai][bj][m][1] * rr;
                        u32x4 w; w.x = cvt_pk_bf16(v0[0], v0[1]); w.y = cvt_pk_bf16(v0[2], v0[3]); w.z = cvt_pk_bf16(v1[0], v1[1]); w.w = cvt_pk_bf16(v1[2], v1[3]);
                        *(u32x4*)(rowp + bj * HALF) = w;
                        if (fo) { *(f32x4*)(fo + bj * HALF) = v0; *(f32x4*)(fo + bj * HALF + 4) = v1; } } }
        }
    }
};
struct EpiF32 {
    static constexpr bool PERM = false, AFTER_DRAIN = false;
    bf16_t* O; int ldc; float* P; int prow0; size_t pstride;
    int par; __device__ __forceinline__ void prefetch(const Unit&, int, int, int, PG8_LAS unsigned char*) {}
    __device__ __forceinline__ void operator()(const f32x4 (&acc)[2][2][4][2], const Unit& u, int wr, int wc, int fr, int fq) const {
        const int row0 = u.pm * BM + wr * 64 + fr, col0 = u.pn * BM + wc * 32 + 4 * fq;
        if (u.nt) {
            float* base = P + (size_t)u.ks * pstride - (size_t)prow0 * ldc;
#pragma unroll
            for (int ai = 0; ai < 2; ++ai)
#pragma unroll
                for (int m = 0; m < 4; ++m) { float* rowp = base + (size_t)(row0 + ai * HALF + m * 16) * ldc + col0;
#pragma unroll
                    for (int bj = 0; bj < 2; ++bj)
#pragma unroll
                        for (int n = 0; n < 2; ++n) *(f32x4*)(rowp + bj * HALF + n * 16) = acc[ai][bj][m][n]; }
        } else {
#pragma unroll
            for (int ai = 0; ai < 2; ++ai)
#pragma unroll
                for (int m = 0; m < 4; ++m) { bf16_t* rowp = O + (size_t)(row0 + ai * HALF + m * 16) * ldc + col0;
#pragma unroll
                    for (int bj = 0; bj < 2; ++bj)
#pragma unroll
                        for (int n = 0; n < 2; ++n) { const f32x4 v = acc[ai][bj][m][n]; u32x2v w; w.x = cvt_pk_bf16(v[0], v[1]); w.y = cvt_pk_bf16(v[2], v[3]); *(u32x2v*)(rowp + bj * HALF + n * 16) = w; } }
        }
    }
};

struct EpiUp {
    static constexpr bool PERM = true, AFTER_DRAIN = false;
    bf16_t* HF; const float* cw; const float* cb; float* GT; float* GH; float* VH; const float* rs;
    int par; PG8_LAS unsigned char* ldsb;
    __device__ __forceinline__ void prefetch(const Unit& u, int p, int wid, int lane, PG8_LAS unsigned char* lds) {
        ldsb = lds;
        if (wid < 4) __builtin_amdgcn_global_load_lds((const unsigned*)(rs + (size_t)u.pm * BM + wid * 64 + lane), (PG8_LAS unsigned*)(lds + 131072 + p * 1024 + wid * 256), 4, 0, 0);
        const int arr = wid >> 1, hf = wid & 1;
        const float* src = (arr < 3 ? cw + (size_t)arr * 5632 : cb) + 128 * u.pn + hf * 64 + lane;
        __builtin_amdgcn_global_load_lds((const unsigned*)src, (PG8_LAS unsigned*)(lds + 133120 + p * 2048 + arr * 512 + hf * 256), 4, 0, 0);
    }
    __device__ __forceinline__ void operator()(const f32x4 (&acc)[2][2][4][2], const Unit& u, int wr, int wc, int fr, int fq) const {
        const int lane = fr | (fq << 4);
        const int src1 = (lane & 48) | ((fr + 15) & 15), src2 = (lane & 48) | ((fr + 14) & 15);
        const int jb = 128 * u.pn + 32 * wc + 8 * fq;
#pragma unroll
        for (int n = 0; n < 2; ++n) {
            const int j0 = jb + 4 * n;
            const PG8_LAS float* cwl = (const PG8_LAS float*)(ldsb + 133120 + par * 2048) + 32 * wc + 8 * fq + 4 * n;
            const f32x4 w0 = *(const PG8_LAS f32x4*)cwl, w1 = *(const PG8_LAS f32x4*)(cwl + 128), w2 = *(const PG8_LAS f32x4*)(cwl + 256), bb = *(const PG8_LAS f32x4*)(cwl + 384);
#pragma unroll
            for (int ai = 0; ai < 2; ++ai) {
                f32x4 p1 = (f32x4){0.f, 0.f, 0.f, 0.f}, p2 = p1;
#pragma unroll
                for (int m = 0; m < 4; ++m) {
                    const float rr = ((const PG8_LAS float*)(ldsb + 131072 + par * 1024))[ai * HALF + wr * 64 + m * 16 + fr];
                    const f32x4 G = acc[ai][0][m][n] * rr, V = acc[ai][1][m][n] * rr;
                    f32x4 r1, r2;
#pragma unroll
                    for (int e = 0; e < 4; ++e) { r1[e] = __shfl(G[e], src1); r2[e] = __shfl(G[e], src2); }
                    const f32x4 g1 = fr >= 1 ? r1 : p1, g2 = fr >= 2 ? r2 : p2;
                    const f32x4 c = bb + w0 * g2 + w1 * g1 + w2 * G;
                    f32x4 h;
#pragma unroll
                    for (int e = 0; e < 4; ++e) h[e] = c[e] * __builtin_amdgcn_rcpf(1.f + __expf(-c[e])) * V[e];
                    const int row = u.pm * BM + ai * HALF + wr * 64 + m * 16 + fr;
                    if (m == 0 && fr < 2) { const size_t o = ((size_t)(row >> 6) * 2 + fr) * 5632 + j0; *(f32x4*)(GH + o) = G; *(f32x4*)(VH + o) = V; }
                    else { u32x2v w; w.x = cvt_pk_bf16(h[0], h[1]); w.y = cvt_pk_bf16(h[2], h[3]); *(u32x2v*)(HF + (size_t)row * 5632 + j0) = w; }
                    if (m == 3 && fr >= 14) { const size_t o = ((size_t)(row >> 6) * 2 + (fr - 14)) * 5632 + j0; *(f32x4*)(GT + o) = G; }
                    p1 = r1; p2 = r2;
                }
            }
        }
    }
};
template <class Epi, class Sched, bool ALIGN_EPI = false, bool SP2 = false>
__device__ __forceinline__ void gemm_phase(PG8_LAS unsigned char* lds, const Gemm g, const Sched& S, const Epi& E_) {
    Epi E = E_;
    const int tid = opq_tid(), wid = __builtin_amdgcn_readfirstlane(tid >> 6), lane = tid & 63, wr = wid >> 2, wc = wid & 3, fr = lane & 15, fq = lane >> 4;
    const int K = g.K, nt = K / BK;
    unsigned voffA[2], voffB[2];
#pragma unroll
    for (int i = 0; i < 2; ++i) { int R, C; stage_rc(tid * 16 + i * 8192, R, C); const int Rb = Epi::PERM ? ((R & ~31) + perm32(R & 31)) : R;
        voffA[i] = (unsigned)(R * K + C) * 2u; voffB[i] = (unsigned)(Rb * K + C) * 2u; }
    const size_t kstep = (size_t)(BK * 2);
    const size_t hstep = (size_t)HALF * K * 2;
    const size_t tstep = 2 * hstep;
    const unsigned ldsw = (unsigned)wid * 1024u;
    const int aoff = lds_byte(wr * 64 + fr, fq * 8), boff = lds_byte(wc * 32 + fr, fq * 8);
#define PG8_SA(b, h) (((b) * 2 + (h)) * HTB)
#define PG8_SB(b, h) ((4 + (b) * 2 + (h)) * HTB)
#define PG8_STAGE(bufoff, gbase, voff) do { _Pragma("unroll") for (int _i = 0; _i < 2; ++_i) \
        __builtin_amdgcn_global_load_lds((const unsigned*)((const char*)(gbase) + (voff)[_i]), (PG8_LAS unsigned*)(lds + (bufoff) + ldsw + _i * 8192), 16, 0, 0); } while (0)
#define PG8_LDA(dst, b, h) do { _Pragma("unroll") for (int m = 0; m < 4; ++m) _Pragma("unroll") for (int k = 0; k < 2; ++k) dst[m][k] = *(const PG8_LAS bf16x8*)(lds + PG8_SA(b, h) + aoff + m * 2048 + k * 1024); } while (0)
#define PG8_LDB(dst, b, h) do { _Pragma("unroll") for (int n = 0; n < 2; ++n) _Pragma("unroll") for (int k = 0; k < 2; ++k) dst[n][k] = *(const PG8_LAS bf16x8*)(lds + PG8_SB(b, h) + boff + n * 2048 + k * 1024); } while (0)
#define PG8_MMA(ai, bj, At, Bt) do { __builtin_amdgcn_s_setprio(1); _Pragma("unroll") for (int m = 0; m < 4; ++m) _Pragma("unroll") for (int n = 0; n < 2; ++n) _Pragma("unroll") for (int k = 0; k < 2; ++k) \
        acc[ai][bj][m][n] = __builtin_amdgcn_mfma_f32_16x16x32_bf16(Bt[n][k], At[m][k], acc[ai][bj][m][n], 0, 0, 0); __builtin_amdgcn_s_setprio(0); } while (0)
#define PG8_WAIT_V(n) asm volatile("s_waitcnt vmcnt(" #n ")" ::: "memory")
#define PG8_WAIT_L(n) asm volatile("s_waitcnt lgkmcnt(" #n ")" ::: "memory")
#define PG8_BAR __builtin_amdgcn_s_barrier()
#define PG8_SCHED __builtin_amdgcn_sched_barrier(0)
    Unit cur, nxt; int ui = 0;
    if (!S.next(0, cur)) return;
    f32x4 acc[2][2][4][2];
#pragma unroll
    for (int a = 0; a < 2; ++a)
#pragma unroll
        for (int b = 0; b < 2; ++b)
#pragma unroll
            for (int m = 0; m < 4; ++m)
#pragma unroll
                for (int n = 0; n < 2; ++n) acc[a][b][m][n] = (f32x4){0.f, 0.f, 0.f, 0.f};
    bf16x8 At[4][2], B0[2][2], B1[2][2];
    const char* cA = (const char*)g.A + (size_t)cur.pm * tstep + (size_t)cur.ks * cur.nt * (BK * 2); const char* cB = (const char*)g.Bt + (size_t)cur.pn * tstep + (size_t)cur.ks * cur.nt * (BK * 2);
    S.a_ready(cur);
    E.prefetch(cur, 0, wid, lane, lds);
    if constexpr (SP2) {
        PG8_STAGE(PG8_SB(0, 0), cB, voffB); PG8_STAGE(PG8_SB(0, 1), cB + hstep, voffB); PG8_STAGE(PG8_SA(0, 0), cA, voffA); PG8_STAGE(PG8_SA(0, 1), cA + hstep, voffA);
        if (wr == 1) PG8_BAR;
        PG8_WAIT_V(2); PG8_BAR;
        PG8_STAGE(PG8_SB(1, 0), cB + kstep, voffB); PG8_STAGE(PG8_SA(1, 0), cA + kstep, voffA); PG8_STAGE(PG8_SB(1, 1), cB + hstep + kstep, voffB);
        PG8_WAIT_V(6); PG8_BAR;
    } else {
        PG8_STAGE(PG8_SB(0, 0), cB, voffB); PG8_STAGE(PG8_SA(0, 0), cA, voffA); PG8_STAGE(PG8_SB(0, 1), cB + hstep, voffB); PG8_STAGE(PG8_SA(0, 1), cA + hstep, voffA);
        if (wr == 1) PG8_BAR;
        PG8_WAIT_V(4); PG8_BAR;
        PG8_STAGE(PG8_SB(1, 0), cB + kstep, voffB); PG8_STAGE(PG8_SA(1, 0), cA + kstep, voffA); PG8_STAGE(PG8_SB(1, 1), cB + hstep + kstep, voffB);
        PG8_WAIT_V(6); PG8_BAR;
    }
    for (;;) {
        const bool has_next = S.next(ui + 1, nxt);
        const char* nA = has_next ? (const char*)g.A + (size_t)nxt.pm * tstep + (size_t)nxt.ks * nxt.nt * (BK * 2) : cA; const char* nB = has_next ? (const char*)g.Bt + (size_t)nxt.pn * tstep + (size_t)nxt.ks * nxt.nt * (BK * 2) : cB;
        const int ntu = cur.nt ? cur.nt : nt;
        for (int t = 0; t < ntu; t += 2) {
            const bool last = (t == ntu - 2);
            const char* a1 = cA + (size_t)(t + 1) * kstep;
            const char* a2 = last ? nA : cA + (size_t)(t + 2) * kstep; const char* b2 = last ? nB : cB + (size_t)(t + 2) * kstep;
            const char* a3 = a2 + kstep; const char* b3 = b2 + kstep;
            if (last && has_next) S.a_ready(nxt);
            if constexpr (SP2) {
            PG8_LDB(B0, 0, 0); PG8_LDB(B1, 0, 1); PG8_SCHED; PG8_LDA(At, 0, 0); PG8_STAGE(PG8_SA(1, 1), a1 + hstep, voffA);
            PG8_WAIT_V(8); PG8_WAIT_L(0); PG8_BAR; PG8_MMA(0, 0, At, B0); PG8_MMA(0, 1, At, B1); PG8_BAR; PG8_SCHED;
            PG8_LDA(At, 0, 1); PG8_STAGE(PG8_SB(0, 0), b2, voffB); PG8_STAGE(PG8_SB(0, 1), b2 + hstep, voffB); PG8_STAGE(PG8_SA(0, 0), a2, voffA);
            PG8_WAIT_V(8); PG8_WAIT_L(0); PG8_BAR; PG8_MMA(1, 0, At, B0); PG8_MMA(1, 1, At, B1); PG8_BAR; PG8_SCHED;
            PG8_LDB(B0, 1, 0); PG8_LDB(B1, 1, 1); PG8_SCHED; PG8_LDA(At, 1, 0); PG8_STAGE(PG8_SA(0, 1), a2 + hstep, voffA);
            PG8_WAIT_V(8); PG8_WAIT_L(0); PG8_BAR; PG8_MMA(0, 0, At, B0); PG8_MMA(0, 1, At, B1); PG8_BAR; PG8_SCHED;
            PG8_LDA(At, 1, 1); PG8_STAGE(PG8_SB(1, 0), b3, voffB); PG8_STAGE(PG8_SB(1, 1), b3 + hstep, voffB); PG8_STAGE(PG8_SA(1, 0), a3, voffA);
            PG8_WAIT_V(8); PG8_WAIT_L(0); PG8_BAR; PG8_MMA(1, 0, At, B0); PG8_MMA(1, 1, At, B1); PG8_BAR; PG8_SCHED;
            } else {
            PG8_LDB(B0, 0, 0); PG8_SCHED; PG8_LDA(At, 0, 0); PG8_STAGE(PG8_SA(1, 1), a1 + hstep, voffA);
            PG8_WAIT_L(8); PG8_BAR; PG8_WAIT_L(0); PG8_MMA(0, 0, At, B0); PG8_BAR; PG8_SCHED;
            PG8_LDB(B1, 0, 1); PG8_STAGE(PG8_SB(0, 0), b2, voffB);
            PG8_BAR; PG8_WAIT_L(0); PG8_MMA(0, 1, At, B1); PG8_BAR;
            PG8_LDA(At, 0, 1); PG8_STAGE(PG8_SA(0, 0), a2, voffA);
            PG8_BAR; PG8_WAIT_L(0); PG8_MMA(1, 0, At, B0); PG8_BAR; PG8_SCHED;
            PG8_STAGE(PG8_SB(0, 1), b2 + hstep, voffB);
            PG8_WAIT_V(6); PG8_BAR; PG8_MMA(1, 1, At, B1); PG8_BAR;
            PG8_LDB(B0, 1, 0); PG8_SCHED; PG8_LDA(At, 1, 0); PG8_STAGE(PG8_SA(0, 1), a2 + hstep, voffA);
            PG8_WAIT_L(8); PG8_BAR; PG8_WAIT_L(0); PG8_MMA(0, 0, At, B0); PG8_BAR; PG8_SCHED;
            PG8_LDB(B1, 1, 1); PG8_STAGE(PG8_SB(1, 0), b3, voffB);
            PG8_BAR; PG8_WAIT_L(0); PG8_MMA(0, 1, At, B1); PG8_BAR;
            PG8_LDA(At, 1, 1); PG8_STAGE(PG8_SA(1, 0), a3, voffA);
            PG8_BAR; PG8_WAIT_L(0); PG8_MMA(1, 0, At, B0); PG8_BAR; PG8_SCHED;
            PG8_STAGE(PG8_SB(1, 1), b3 + hstep, voffB);
            PG8_WAIT_V(6); PG8_BAR; PG8_MMA(1, 1, At, B1); PG8_BAR;
            }
        }
        if constexpr (ALIGN_EPI) { if (wr == 0) PG8_BAR; }
        if constexpr (!Epi::AFTER_DRAIN) { E.par = ui & 1; E(acc, cur, wr, wc, fr, fq); S.done(cur); }
        if (!has_next) break;
        E.prefetch(nxt, (ui + 1) & 1, wid, lane, lds);
#pragma unroll
        for (int a = 0; a < 2; ++a)
#pragma unroll
            for (int b = 0; b < 2; ++b)
#pragma unroll
                for (int m = 0; m < 4; ++m)
#pragma unroll
                    for (int n = 0; n < 2; ++n) acc[a][b][m][n] = (f32x4){0.f, 0.f, 0.f, 0.f};
        cur = nxt; cA = nA; cB = nB; ++ui;
        if constexpr (ALIGN_EPI) { if (wr == 1) PG8_BAR; }
    }
    PG8_WAIT_V(0);
    if constexpr (!ALIGN_EPI) { if (wr == 0) PG8_BAR; }
    PG8_BAR;
    if constexpr (Epi::AFTER_DRAIN) { E.fused(acc, cur, wr, wc, fr, fq, lds, wid, lane); S.done(cur); }
#undef PG8_SA
#undef PG8_SB
#undef PG8_STAGE
#undef PG8_LDA
#undef PG8_LDB
#undef PG8_MMA
#undef PG8_WAIT_V
#undef PG8_WAIT_L
#undef PG8_BAR
#undef PG8_SCHED
}
}
#define XB_TMO      128
#define XB_XCNT(j)  (256  + 64 * (j))
#define XB_XSUB(j)  (1280 + 64 * (j))
#define XB_XGEN(j)  (2304 + 64 * (j))
#define XB_TOP      3328
#define XB_TOPGEN   3392
#define XCD_BAR_WORDS 3456
#define XB_SPIN_CAP (1u << 18)

__device__ __forceinline__ unsigned xb_ld(unsigned* p)              { return __hip_atomic_load(p, __ATOMIC_RELAXED, __HIP_MEMORY_SCOPE_AGENT); }
__device__ __forceinline__ unsigned xb_add(unsigned* p, unsigned v) { return __hip_atomic_fetch_add(p, v, __ATOMIC_RELAXED, __HIP_MEMORY_SCOPE_AGENT); }
__device__ __forceinline__ unsigned xb_xcc_id() { return (unsigned)__builtin_amdgcn_s_getreg((3 << 11) | 20) & 0xFu; }
#define XB_SPIN(cond, bar) do { unsigned _sp = 0; while (cond) { __builtin_amdgcn_s_sleep(1); \
    if ((++_sp & 255u) == 0u) { if (xb_ld(&(bar)[XB_TMO])) break; if (_sp > XB_SPIN_CAP) { atomicAdd(&(bar)[XB_TMO], 1u); break; } } } } while (0)

struct XcdBarrier {
    unsigned* bar; unsigned x;
    volatile LAS unsigned* st;
};

__device__ __forceinline__ XcdBarrier xcd_barrier_post(unsigned* bar, volatile LAS unsigned* st) {
    XcdBarrier b; b.bar = bar; b.x = xb_xcc_id(); b.st = st;
    if (threadIdx.x == 0) (void)xb_add(&bar[XB_XCNT(b.x)], 1u);
    return b;
}
__device__ __forceinline__ void xcd_barrier_complete(unsigned* bar, unsigned x, unsigned& nloc, unsigned& nx) {
    const unsigned G = gridDim.x * gridDim.y * gridDim.z;
    unsigned sum, cnt, mine, sp = 0u;
    for (;;) {
        sum = 0u; cnt = 0u; mine = 0u;
#pragma unroll
        for (unsigned j = 0; j < 16; ++j) { const unsigned c = xb_ld(&bar[XB_XCNT(j)]); sum += c; cnt += (c > 0u) ? 1u : 0u; mine = (j == x) ? c : mine; }
        if (sum == G) break;
        __builtin_amdgcn_s_sleep(1);
        if ((++sp & 255u) == 0u) { if (xb_ld(&bar[XB_TMO])) break; if (sp > XB_SPIN_CAP) { atomicAdd(&bar[XB_TMO], 1u); break; } }
    }
    nloc = mine > 0u ? mine : 1u; nx = cnt > 0u ? cnt : 1u;
}

__device__ __forceinline__ void xcd_barrier(const XcdBarrier& b) {
    asm volatile("s_waitcnt vmcnt(0)" ::: "memory");
    __syncthreads();
    if (threadIdx.x == 0) {
        unsigned* bar = b.bar;
        __builtin_amdgcn_s_waitcnt(0);
        unsigned nloc = b.st[0], nx = b.st[1];
        if (nloc == 0u) { xcd_barrier_complete(bar, b.x, nloc, nx); b.st[0] = nloc; b.st[1] = nx; }
        const unsigned old = xb_add(&bar[XB_XSUB(b.x)], 1u);
        const unsigned gen = old / nloc;
        if (old + 1u == (gen + 1u) * nloc) {
            __builtin_amdgcn_fence(__ATOMIC_RELEASE, "agent");
            asm volatile("s_waitcnt vmcnt(0)" ::: "memory");
            const unsigned og = xb_add(&bar[XB_TOP], 1u);
            const unsigned tg = og / nx;
            if (og + 1u == (tg + 1u) * nx) xb_add(&bar[XB_TOPGEN], 1u);
            else XB_SPIN(xb_ld(&bar[XB_TOPGEN]) == tg, bar);
            __builtin_amdgcn_fence(__ATOMIC_ACQUIRE, "agent");
            xb_add(&bar[XB_XGEN(b.x)], 1u);
            asm volatile("s_waitcnt vmcnt(0)" ::: "memory");
        } else {
            XB_SPIN(xb_ld(&bar[XB_XGEN(b.x)]) == gen, bar);
            __builtin_amdgcn_fence(__ATOMIC_ACQUIRE, "agent");
            asm volatile("s_waitcnt vmcnt(0)" ::: "memory");
        }
    }
    __syncthreads();
}
namespace cg = cooperative_groups;
#define LAS __attribute__((address_space(3)))
typedef unsigned short bf16_t;
typedef short bf16x8 __attribute__((ext_vector_type(8)));
typedef short s16x4 __attribute__((ext_vector_type(4)));
typedef float f32x4 __attribute__((ext_vector_type(4)));
typedef float f32x16 __attribute__((ext_vector_type(16)));
typedef unsigned u32x4 __attribute__((ext_vector_type(4)));
typedef unsigned u32x2 __attribute__((ext_vector_type(2)));

constexpr int DM = 2048, MP = 16384, MS = 1024, M = MP + MS;
constexpr int DFF = 5632, NUP = 2 * DFF, NIN = 6400  , NINR = 6160;
constexpr float EPS = 1e-6f;
constexpr int NWAVES = 8;
constexpr int LDS_BYTES = 147456;
constexpr size_t OUT_Y = 0, OUT_GLAP = 35651584, OUT_GLAS = 39845888, OUT_CONVP = 56623104, OUT_CONVS = 56803328,
                 OUT_KP = 57524224, OUT_VP = 58572800, OUT_KS = 59621376, OUT_VS = 60145664;
constexpr size_t MiB = 1u << 20;
constexpr size_t WS_WIN = 0;
constexpr size_t WS_GWO = 50 * MiB;
constexpr size_t WS_WKVQ = 66 * MiB;
constexpr size_t WS_WQ3 = 78 * MiB;
constexpr size_t WS_AWO = 86 * MiB;
constexpr size_t WS_WUP = 102 * MiB;
constexpr size_t WS_WDN = 278 * MiB;
constexpr size_t WS_H = 366 * MiB;
constexpr size_t WS_MF = 434 * MiB;
constexpr size_t WS_KVP = 570 * MiB;
constexpr size_t WS_KVS = 602 * MiB;
constexpr size_t WS_HF = 620 * MiB;
constexpr size_t WS_O = WS_HF, WS_OG = WS_HF + 68 * MiB, WS_Q = WS_HF;
constexpr size_t WS_SCR = 808 * MiB;
constexpr size_t WS_U = WS_SCR, WS_PROJ = WS_SCR, WS_GPRE = WS_SCR + 213 * MiB;
constexpr size_t GPRE_ITEM = 32768 + 8192 + 65536 + 1024 + 32768;
constexpr size_t WS_UST = WS_H;
constexpr size_t WS_END = WS_SCR + 374 * MiB;
static_assert(WS_GPRE + 1088 * GPRE_ITEM <= WS_END, "gpre fits");
static_assert(WS_UST + (size_t)1088 * 262144 <= WS_OG, "ust fits below OG");
constexpr size_t WS_CTL = WS_END, CTL_BYTES = 65536, WS_END2 = WS_END + MiB;
constexpr size_t WS_GT = WS_END2, WS_GH = WS_GT + 13 * MiB, WS_VH = WS_GH + 13 * MiB, WS_END3 = WS_VH + 13 * MiB;
constexpr size_t WS_MFP = WS_END3, WS_END4 = WS_MFP + 64 * MiB;
constexpr size_t WS_XB = WS_END4, WS_END5 = WS_XB + 68 * MiB;
constexpr size_t WS_RS = WS_END5, WS_END6 = WS_RS + MiB;
constexpr int LDS_BARST = 147392;

__device__ __forceinline__ float bf2f(unsigned v) { return __uint_as_float(v << 16); }
__device__ __forceinline__ unsigned f2bf_sw(float f) { unsigned u = __float_as_uint(f); return (u + 0x7fffu + ((u >> 16) & 1u)) >> 16; }
typedef float f32x2_t __attribute__((ext_vector_type(2))); typedef __bf16 bf16x2_t __attribute__((ext_vector_type(2)));
__device__ __forceinline__ unsigned pk2(float lo, float hi) { f32x2_t v = {lo, hi}; bf16x2_t b = __builtin_convertvector(v, bf16x2_t); return __builtin_bit_cast(unsigned, b); }
__device__ __forceinline__ unsigned pk2_sw(float lo, float hi) { return pk2(lo, hi); }
__device__ __forceinline__ unsigned f2bf(float f) { return pk2(f, f) & 0xffffu; }
__device__ __forceinline__ float wave_sum(float v) {
#pragma unroll
    for (int o = 1; o < 64; o <<= 1) v += __shfl_xor(v, o);
    return v;
}
__device__ __forceinline__ float silu_f(float x) { return x * __builtin_amdgcn_rcpf(1.f + __expf(-x)); }

#define LDS_BARRIER() asm volatile("s_waitcnt lgkmcnt(0)\n\ts_barrier" ::: "memory")
struct Args { const float* in[21]; float* out; unsigned char* ws; int ph_lo, ph_hi; };
typedef const Args __attribute__((address_space(4))) CArgs;
__device__ __forceinline__ CArgs* get_args() { CArgs* p = (CArgs*)__builtin_amdgcn_kernarg_segment_ptr(); asm volatile("" : "+s"(p)); return p; }

__device__ __forceinline__ void tr_load(f32x4 (&v)[16], float (&gv)[16], const float* W, int ldw, int ncols, const float* gain, int item, int lane) {
    const int nblk = ncols / 64, kb = item / nblk, nb = item % nblk, k0 = 64 * kb, n0 = 64 * nb, l16 = lane & 15, r2 = lane >> 4;
#pragma unroll
    for (int j = 0; j < 16; ++j) v[j] = __builtin_nontemporal_load((const f32x4*)(W + (size_t)(k0 + 8 * (j >> 1) + 2 * r2 + (j & 1)) * ldw + n0 + 4 * l16));
#pragma unroll
    for (int j = 0; j < 16; ++j) gv[j] = gain ? gain[k0 + 8 * (j >> 1) + 2 * r2 + (j & 1)] : 1.f;
}
__device__ __forceinline__ void tr_store(const f32x4 (&v)[16], const float (&gv)[16], int K, int ncols, int qcols, float qscale, bf16_t* WT, LAS unsigned* scr, int item, int lane, int permup) {
    const int nblk = ncols / 64, kb = item / nblk, nb = item % nblk, k0 = 64 * kb, n0 = 64 * nb;
    const float sc = (n0 < qcols) ? qscale : 1.f;
    const int nd0 = permup ? 256 * ((n0 % 5632) / 128) + 128 * (n0 / 5632) + (n0 % 128) : n0;
    const int l16 = lane & 15, r2 = lane >> 4;
#pragma unroll
    for (int jp = 0; jp < 8; ++jp) {
        const float g0 = gv[2 * jp] * sc, g1 = gv[2 * jp + 1] * sc;
#pragma unroll
        for (int i = 0; i < 4; ++i) scr[(4 * l16 + i) * 33 + 4 * jp + r2] = pk2(v[2 * jp][i] * g0, v[2 * jp + 1][i] * g1);
    }
    asm volatile("s_waitcnt lgkmcnt(0)" ::: "memory");
    const int c = lane & 7;
#pragma unroll
    for (int jj = 0; jj < 8; ++jj) { const int n = (lane >> 3) + 8 * jj; const LAS unsigned* s = scr + n * 33 + 4 * c;
        u32x4 o; o.x = s[0]; o.y = s[1]; o.z = s[2]; o.w = s[3];
        *(u32x4*)(WT + (size_t)(nd0 + n) * K + k0 + 8 * c) = o; }
    asm volatile("s_waitcnt lgkmcnt(0)" ::: "memory");
}

__device__ __forceinline__ void kvs_cache_convert(CArgs* a, int vcu, int G) {
    const int tid = opq_tid(); unsigned char* ws = a->ws;
    const int gt = vcu * 512 + tid, NT = G * 512;
    for (int i = gt; i < 16 * 512 * 128; i += NT) {
        const int bp = i >> 7, c4 = (i & 127) * 4;
        const f32x4 kv = *(const f32x4*)(a->in[4] + (size_t)bp * 512 + c4), vv = *(const f32x4*)(a->in[5] + (size_t)bp * 512 + c4);
        const int b = bp >> 9, p = bp & 511;
        bf16_t* dst = (bf16_t*)(ws + WS_KVS) + ((size_t)b * 576 + p) * 1024 + c4;
        u32x2 w; w.x = pk2(kv[0], kv[1]); w.y = pk2(kv[2], kv[3]); *(u32x2*)dst = w;
        w.x = pk2(vv[0], vv[1]); w.y = pk2(vv[2], vv[3]); *(u32x2*)(dst + 512) = w;
    }
}

#define P0_JOB(idx_, jW, jldw, jK, jncols, jgain, jqcols, jqscale, jWT, jperm, jit) do { int r_ = (idx_), j_ = 0; \
        if (r_ >= 3072) { r_ -= 3072; j_ = 1; if (r_ >= 3072) { r_ -= 3072; j_ = 2; if (r_ >= 1024) { r_ -= 1024; j_ = 3; if (r_ >= 1024) { r_ -= 1024; j_ = 4; if (r_ >= 512) { r_ -= 512; j_ = 5; \
        if (r_ >= 1024) { r_ -= 1024; j_ = 6; if (r_ >= 1024) { r_ -= 1024; j_ = 7; if (r_ >= 1024) { r_ -= 1024; j_ = 8; if (r_ >= 1024) { r_ -= 1024; j_ = 9 + r_ / 5632; r_ = r_ % 5632; \
        if (j_ >= 13) { r_ = (idx_) - 35328; j_ = 13 + r_ / 2816; r_ = r_ % 2816; } } } } } } } } } } \
        jit = r_; jqcols = 0; jgain = nullptr; jqscale = 1.f; jperm = 0; const int j = j_; \
        if (j < 2)       { jW = a->in[7] + (size_t)j * 2048 * NINR; jldw = NINR; jK = 2048; jncols = 6144; jgain = gains + (j * 4 + 0) * 2048; jqcols = 1024; jqscale = 0.0625f; jWT = (bf16_t*)(ws + WS_WIN) + (size_t)j * NIN * 2048; } \
        else if (j < 4)  { const int l = j - 2; jW = a->in[11] + (size_t)l * 2048 * 2048; jldw = 2048; jK = 2048; jncols = 2048; jWT = (bf16_t*)(ws + WS_GWO) + (size_t)l * 2048 * 2048; } \
        else if (j == 4) { jW = a->in[13]; jldw = 1024; jK = 2048; jncols = 1024; jgain = a->in[12]; jWT = (bf16_t*)(ws + WS_WKVQ); } \
        else if (j == 5) { jW = a->in[14]; jldw = 2048; jK = 2048; jncols = 2048; jgain = gains + (2 * 4 + 0) * 2048; jqcols = 2048; jqscale = 0.12751743074602625f  ; jWT = (bf16_t*)(ws + WS_WKVQ) + (size_t)1024 * 2048; } \
        else if (j == 6) { jW = a->in[14] + (size_t)2048 * 2048; jldw = 2048; jK = 2048; jncols = 2048; jgain = gains + (3 * 4 + 0) * 2048; jqcols = 2048; jqscale = 0.12751743074602625f; jWT = (bf16_t*)(ws + WS_WQ3); } \
        else if (j < 9)  { const int l = j - 7; jW = a->in[16] + (size_t)l * 2048 * 2048; jldw = 2048; jK = 2048; jncols = 2048; jWT = (bf16_t*)(ws + WS_AWO) + (size_t)l * 2048 * 2048; } \
        else if (j < 13) { const int l = j - 9; jW = a->in[17] + (size_t)l * 2048 * NUP; jldw = NUP; jK = 2048; jncols = NUP; jgain = gains + (l * 4 + 2) * 2048; jWT = (bf16_t*)(ws + WS_WUP) + (size_t)l * NUP * 2048; jperm = 1; } \
        else             { const int l = j - 13; jW = a->in[20] + (size_t)l * DFF * 2048; jldw = 2048; jK = DFF; jncols = 2048; jWT = (bf16_t*)(ws + WS_WDN) + (size_t)l * 2048 * DFF; } } while (0)
__device__ __forceinline__ int layer_tile(int L, int v) {
    if (L < 2) { if (v < 3072) return L * 3072 + v; v -= 3072; if (v < 1024) return 6144 + L * 1024 + v; v -= 1024; if (v < 5632) return 12800 + L * 5632 + v; v -= 5632; return 35328 + L * 2816 + v; }
    if (L == 2) { if (v < 512) return 8192 + v; v -= 512; if (v < 1024) return 8704 + v; v -= 1024; if (v < 1024) return 10752 + v; v -= 1024; if (v < 5632) return 12800 + 2 * 5632 + v; v -= 5632; return 35328 + 2 * 2816 + v; }
    if (v < 1024) return 9728 + v; v -= 1024; if (v < 1024) return 11776 + v; v -= 1024; if (v < 5632) return 12800 + 3 * 5632 + v; v -= 5632; return 35328 + 3 * 2816 + v;
}
__device__ __forceinline__ void convert_layer_tiles(CArgs* a, LAS unsigned char* lds, int L, int v0, int v1, int widx, int nw) {
    const int tid = opq_tid(), lane = tid & 63, wave = __builtin_amdgcn_readfirstlane(tid >> 6);
    LAS unsigned* scr = (LAS unsigned*)(lds + wave * 16384);
    unsigned char* ws = a->ws; const float* gains = a->in[6];
    f32x4 v[16], vn[16]; float gv[16], gn[16];
    const float* cW; int cldw, cK, cncols, cqcols, cperm, cit; const float* cgain; float cqscale; bf16_t* cWT;
    int vi = v0 + widx;
    if (vi < v1) { P0_JOB(layer_tile(L, vi), cW, cldw, cK, cncols, cgain, cqcols, cqscale, cWT, cperm, cit); tr_load(v, gv, cW, cldw, cncols, cgain, cit, lane); }
    while (vi < v1) {
        const int nx = vi + nw;
        const float* nW = cW; int nldw = cldw, nK = cK, nncols = cncols, nqcols = cqcols, nperm = cperm, nit = cit; const float* ngain = cgain; float nqscale = cqscale; bf16_t* nWT = cWT;
        if (nx < v1) { P0_JOB(layer_tile(L, nx), nW, nldw, nK, nncols, ngain, nqcols, nqscale, nWT, nperm, nit); tr_load(vn, gn, nW, nldw, nncols, ngain, nit, lane); }
        tr_store(v, gv, cK, cncols, cqcols, cqscale, cWT, scr, cit, lane, cperm);
#pragma unroll
        for (int q = 0; q < 16; ++q) { v[q] = vn[q]; gv[q] = gn[q]; }
        cW = nW; cldw = nldw; cK = nK; cncols = nncols; cgain = ngain; cqcols = nqcols; cqscale = nqscale; cWT = nWT; cperm = nperm; cit = nit;
        vi = nx;
    }
}
__device__ __forceinline__ void convert_in_phase(CArgs* a, LAS unsigned char* lds, int G, int bx, int l, int rem, int pf0, int pf1) {
    if (G != 256 || l >= 3 || bx < rem) return;
    const int NT = (l + 1 < 2) ? 12544 : (l + 1 == 2 ? 11008 : 10496);
    const int p0 = (int)((long)NT * pf0 / 1024), p1 = (int)((long)NT * pf1 / 1024), nI = 256 - rem, cnt = (p1 - p0 + nI - 1) / nI;
    const int v0 = p0 + (bx - rem) * cnt, v1 = (v0 + cnt < p1) ? v0 + cnt : p1;
    const int wave = __builtin_amdgcn_readfirstlane((int)(threadIdx.x >> 6));
    __syncthreads();
    convert_layer_tiles(a, lds, l + 1, v0, v1, wave, 8);
}
__device__ __forceinline__ void p0_prologue(CArgs* a, LAS unsigned char* lds, int vcu, int G) {
    const int tid = opq_tid(), lane = tid & 63, wave = __builtin_amdgcn_readfirstlane(tid >> 6);
    LAS unsigned* scr = (LAS unsigned*)(lds + wave * 16384);
    const int gw = vcu * NWAVES + wave, NGW = G * NWAVES;
    unsigned char* ws = a->ws;
    const float* gains = a->in[6];
    if (G == 256) convert_layer_tiles(a, lds, 0, 0, 12544, gw, NGW);
    else { convert_layer_tiles(a, lds, 0, 0, 12544, gw, NGW); convert_layer_tiles(a, lds, 1, 0, 12544, gw, NGW); convert_layer_tiles(a, lds, 2, 0, 11008, gw, NGW); convert_layer_tiles(a, lds, 3, 0, 10496, gw, NGW); }
    const int gt = vcu * 512 + tid, NT = G * 512;
    for (int i = gt; i < 2 * 2048 * 256; i += NT) {
        const int l = i / (2048 * 256), r = i % (2048 * 256), n = r / 2048, k = r % 2048;
        float v = 0.f;
        if (n < 16) v = a->in[7][((size_t)l * 2048 + k) * NINR + 6144 + n] * gains[(l * 4 + 0) * 2048 + k];
        ((bf16_t*)(ws + WS_WIN))[((size_t)l * NIN + 6144 + n) * 2048 + k] = (bf16_t)f2bf(v);
    }
    {
        f32x4 v[8], vn[8];
        int row = gw;
        if (row < M) { const float* xr = row < MP ? a->in[0] + (size_t)row * DM : a->in[1] + (size_t)(row - MP) * DM;
#pragma unroll
            for (int j = 0; j < 8; ++j) v[j] = __builtin_nontemporal_load((const f32x4*)(xr + 4 * lane + 256 * j)); }
        for (; row < M; row += NGW) {
            const int nr = row + NGW;
            if (nr < M) { const float* xr = nr < MP ? a->in[0] + (size_t)nr * DM : a->in[1] + (size_t)(nr - MP) * DM;
#pragma unroll
                for (int j = 0; j < 8; ++j) vn[j] = __builtin_nontemporal_load((const f32x4*)(xr + 4 * lane + 256 * j)); }
            float s = 0.f;
#pragma unroll
            for (int j = 0; j < 8; ++j) s += (v[j][0] * v[j][0] + v[j][1] * v[j][1]) + (v[j][2] * v[j][2] + v[j][3] * v[j][3]);
            const float r = rsqrtf(wave_sum(s) * (1.f / DM) + EPS);
            bf16_t* hr = (bf16_t*)(ws + WS_XB) + (size_t)row * DM;
#pragma unroll
            for (int j = 0; j < 8; ++j) { u32x2 w; w.x = pk2(v[j][0], v[j][1]); w.y = pk2(v[j][2], v[j][3]); *(u32x2*)(hr + 4 * lane + 256 * j) = w; }
            if (lane == 0) ((float*)(ws + WS_RS))[row] = r;
#pragma unroll
            for (int j = 0; j < 8; ++j) v[j] = vn[j];
        }
    }
}

template <bool LAST> __device__ __forceinline__ void norm_row(f32x4 (&xv)[8], const f32x4 (&mv)[8], const f32x4 (&g)[8], float* xo32, bf16_t* xo16, bf16_t* hr, int lane) {
    constexpr bool want_h = !LAST;
    float s = 0.f;
#pragma unroll
    for (int j = 0; j < 8; ++j) s += (mv[j][0] * mv[j][0] + mv[j][1] * mv[j][1]) + (mv[j][2] * mv[j][2] + mv[j][3] * mv[j][3]);
    const float r1 = rsqrtf(wave_sum(s) * (1.f / DM) + EPS);
    float s2 = 0.f;
#pragma unroll
    for (int j = 0; j < 8; ++j) { xv[j] = xv[j] + mv[j] * r1 * g[j];
        s2 += (xv[j][0] * xv[j][0] + xv[j][1] * xv[j][1]) + (xv[j][2] * xv[j][2] + xv[j][3] * xv[j][3]);
        if (LAST) *(f32x4*)(xo32 + 4 * lane + 256 * j) = xv[j];
        else { u32x2 w; w.x = pk2(xv[j][0], xv[j][1]); w.y = pk2(xv[j][2], xv[j][3]); *(u32x2*)(xo16 + 4 * lane + 256 * j) = w; } }
    if (want_h) {
        const float r2 = rsqrtf(wave_sum(s2) * (1.f / DM) + EPS);
        if (lane == 0) *(float*)hr = r2;
    }
}
__device__ __forceinline__ f32x4 unpk4(u32x2 p) { return (f32x4){bf2f(p.x & 0xffffu), bf2f(p.x >> 16), bf2f(p.y & 0xffffu), bf2f(p.y >> 16)}; }
__device__ __forceinline__ void norm_pass(CArgs* a, LAS unsigned char* lds, int vcu, int G, const float* gpost, bool first, bool want_h, int nsplit) {
    const int tid = opq_tid(), lane = tid & 63, wave = tid >> 6;
    const int gw = vcu * NWAVES + wave, NGW = G * NWAVES;
    float* Y = a->out + OUT_Y; bf16_t* XB = (bf16_t*)(a->ws + WS_XB); const bf16_t* MF = (const bf16_t*)(a->ws + WS_MF); float* RS = (float*)(a->ws + WS_RS);
    const bool last = !want_h;
    f32x4 g[8];
#pragma unroll
    for (int j = 0; j < 8; ++j) g[j] = *(const f32x4*)(gpost + 4 * lane + 256 * j);
    if (first) {
        for (int row = gw; row < MP; row += NGW) {
            f32x4 xv[8], mv[8];
#pragma unroll
            for (int j = 0; j < 8; ++j) { xv[j] = *(const f32x4*)(a->in[0] + (size_t)row * DM + 4 * lane + 256 * j); mv[j] = unpk4(*(const u32x2*)(MF + (size_t)row * DM + 4 * lane + 256 * j)); }
            norm_row<false>(xv, mv, g, nullptr, XB + (size_t)row * DM, (bf16_t*)(RS + row), lane);
        }
    } else {
        u32x2 xa[8], xb[8], xc[8], ma[8], mb[8], mc[8];
        int row = gw;
#define NP_LOAD(xd, md, r_) do { _Pragma("unroll") for (int j = 0; j < 8; ++j) { xd[j] = *(const u32x2*)(XB + (size_t)(r_) * DM + 4 * lane + 256 * j); md[j] = *(const u32x2*)(MF + (size_t)(r_) * DM + 4 * lane + 256 * j); } } while (0)
        if (row < MP) NP_LOAD(xa, ma, row);
        if (row + NGW < MP) NP_LOAD(xb, mb, row + NGW);
        for (; row < MP; row += NGW) {
            const int nr = row + 2 * NGW;
            if (nr < MP) NP_LOAD(xc, mc, nr);
            f32x4 xv[8], mv[8];
#pragma unroll
            for (int j = 0; j < 8; ++j) { xv[j] = unpk4(xa[j]); mv[j] = unpk4(ma[j]); }
            if (last) norm_row<true>(xv, mv, g, Y + (size_t)row * DM, nullptr, nullptr, lane); else norm_row<false>(xv, mv, g, nullptr, XB + (size_t)row * DM, (bf16_t*)(RS + row), lane);
#pragma unroll
            for (int j = 0; j < 8; ++j) { xa[j] = xb[j]; ma[j] = mb[j]; xb[j] = xc[j]; mb[j] = mc[j]; }
        }
#undef NP_LOAD
    }
    if (G == 256) {
        LAS float* red = (LAS float*)lds;
        const int rl = wave & 3, hf = wave >> 2, row = MP + 4 * vcu + rl, c0 = 1024 * hf + 4 * lane;
        f32x4 xv[4], mv[4];
#pragma unroll
        for (int j = 0; j < 4; ++j) { xv[j] = unpk4(*(const u32x2*)(XB + (size_t)row * DM + c0 + 256 * j)); mv[j] = (f32x4){0.f, 0.f, 0.f, 0.f}; }
        const float* pp = (const float*)(a->ws + WS_MFP) + (size_t)(row - MP) * DM + c0;
        if (nsplit == 8) { f32x4 p[8][4];
#pragma unroll
            for (int sp = 0; sp < 8; ++sp)
#pragma unroll
                for (int j = 0; j < 4; ++j) p[sp][j] = *(const f32x4*)(pp + (size_t)sp * MS * DM + 256 * j);
#pragma unroll
            for (int j = 0; j < 4; ++j) mv[j] = ((p[0][j] + p[1][j]) + (p[2][j] + p[3][j])) + ((p[4][j] + p[5][j]) + (p[6][j] + p[7][j])); }
        else { f32x4 p[4][4];
#pragma unroll
            for (int sp = 0; sp < 4; ++sp)
#pragma unroll
                for (int j = 0; j < 4; ++j) p[sp][j] = *(const f32x4*)(pp + (size_t)sp * MS * DM + 256 * j);
#pragma unroll
            for (int j = 0; j < 4; ++j) mv[j] = (p[0][j] + p[1][j]) + (p[2][j] + p[3][j]); }
        float s = 0.f;
#pragma unroll
        for (int j = 0; j < 4; ++j) s += (mv[j][0] * mv[j][0] + mv[j][1] * mv[j][1]) + (mv[j][2] * mv[j][2] + mv[j][3] * mv[j][3]);
        s = wave_sum(s);
        __syncthreads();
        if (lane == 0) red[rl * 2 + hf] = s;
        __syncthreads();
        const float r1 = rsqrtf((red[rl * 2] + red[rl * 2 + 1]) * (1.f / DM) + EPS);
        float s2 = 0.f;
#pragma unroll
        for (int j = 0; j < 4; ++j) { const f32x4 gg = *(const f32x4*)(gpost + c0 + 256 * j); xv[j] = xv[j] + mv[j] * r1 * gg;
            s2 += (xv[j][0] * xv[j][0] + xv[j][1] * xv[j][1]) + (xv[j][2] * xv[j][2] + xv[j][3] * xv[j][3]);
            if (last) *(f32x4*)(Y + (size_t)row * DM + c0 + 256 * j) = xv[j];
            else { u32x2 w; w.x = pk2(xv[j][0], xv[j][1]); w.y = pk2(xv[j][2], xv[j][3]); *(u32x2*)(XB + (size_t)row * DM + c0 + 256 * j) = w; } }
        if (!last) {
            s2 = wave_sum(s2);
            if (lane == 0) red[8 + rl * 2 + hf] = s2;
            __syncthreads();
            if (hf == 0 && lane == 0) RS[row] = rsqrtf((red[8 + rl * 2] + red[8 + rl * 2 + 1]) * (1.f / DM) + EPS);
        }
    } else {
#pragma unroll 1
    for (int row = MP + gw; row < M; row += NGW) {
        f32x4 xv[8], mv[8];
#pragma unroll
        for (int j = 0; j < 8; ++j) { xv[j] = unpk4(*(const u32x2*)(XB + (size_t)row * DM + 4 * lane + 256 * j)); mv[j] = (f32x4){0.f, 0.f, 0.f, 0.f}; }
#pragma unroll 1
        for (int sp = 0; sp < nsplit; sp += 2) {
            const float* pp = (const float*)(a->ws + WS_MFP) + (size_t)sp * MS * DM + (size_t)(row - MP) * DM + 4 * lane;
            f32x4 p0[8], p1[8];
#pragma unroll
            for (int j = 0; j < 8; ++j) { p0[j] = *(const f32x4*)(pp + 256 * j); p1[j] = *(const f32x4*)(pp + (size_t)MS * DM + 256 * j); }
#pragma unroll
            for (int j = 0; j < 8; ++j) mv[j] = mv[j] + (p0[j] + p1[j]);
        }
        if (last) norm_row<true>(xv, mv, g, Y + (size_t)row * DM, nullptr, nullptr, lane); else norm_row<false>(xv, mv, g, nullptr, XB + (size_t)row * DM, (bf16_t*)(RS + row), lane);
    }
    }
}

__device__ __forceinline__ void conv_pass(CArgs* a, int vcu, int G, int l) {
    const int tid = opq_tid();
    const int gt = vcu * 512 + tid, NT = G * 512;
    bf16_t* HF = (bf16_t*)(a->ws + WS_HF);
    const float* GT = (const float*)(a->ws + WS_GT); const float* GH = (const float*)(a->ws + WS_GH); const float* VH = (const float*)(a->ws + WS_VH);
    const float* cw = a->in[18] + (size_t)l * 3 * DFF; const float* cb = a->in[19] + (size_t)l * DFF;
    for (int i = gt; i < 272 * 1408; i += NT) {
        const int rb = i / 1408, j0 = (i % 1408) * 4;
        const f32x4 w0 = *(const f32x4*)(cw + j0), w1 = *(const f32x4*)(cw + DFF + j0), w2 = *(const f32x4*)(cw + 2 * DFF + j0), bb = *(const f32x4*)(cb + j0);
        f32x4 gm2 = (f32x4){0.f, 0.f, 0.f, 0.f}, gm1 = gm2;
        if (rb >= 256) { const float* st = a->in[3] + ((size_t)(l * 16 + (rb - 256)) * 2) * DFF + j0; gm2 = *(const f32x4*)st; gm1 = *(const f32x4*)(st + DFF); }
        else if ((rb & 63) != 0) { gm2 = *(const f32x4*)(GT + ((size_t)(rb - 1) * 2) * DFF + j0); gm1 = *(const f32x4*)(GT + ((size_t)(rb - 1) * 2 + 1) * DFF + j0); }
        const f32x4 g0 = *(const f32x4*)(GH + ((size_t)rb * 2) * DFF + j0), g1 = *(const f32x4*)(GH + ((size_t)rb * 2 + 1) * DFF + j0);
        const f32x4 v0 = *(const f32x4*)(VH + ((size_t)rb * 2) * DFF + j0), v1 = *(const f32x4*)(VH + ((size_t)rb * 2 + 1) * DFF + j0);
        const f32x4 c0 = bb + w0 * gm2 + w1 * gm1 + w2 * g0, c1 = bb + w0 * gm1 + w1 * g0 + w2 * g1;
        u32x2 o0, o1;
        o0.x = pk2(silu_f(c0[0]) * v0[0], silu_f(c0[1]) * v0[1]); o0.y = pk2(silu_f(c0[2]) * v0[2], silu_f(c0[3]) * v0[3]);
        o1.x = pk2(silu_f(c1[0]) * v1[0], silu_f(c1[1]) * v1[1]); o1.y = pk2(silu_f(c1[2]) * v1[2], silu_f(c1[3]) * v1[3]);
        *(u32x2*)(HF + (size_t)(rb * 64) * DFF + j0) = o0; *(u32x2*)(HF + (size_t)(rb * 64 + 1) * DFF + j0) = o1;
        float* cout = nullptr;
        if (rb >= 256) cout = a->out + OUT_CONVS + ((size_t)(l * 16 + (rb - 256)) * 2) * DFF + j0;
        else if ((rb & 63) == 63) cout = a->out + OUT_CONVP + ((size_t)(l * 4 + (rb >> 6)) * 2) * DFF + j0;
        if (cout) { *(f32x4*)cout = *(const f32x4*)(GT + ((size_t)rb * 2) * DFF + j0); *(f32x4*)(cout + DFF) = *(const f32x4*)(GT + ((size_t)rb * 2 + 1) * DFF + j0); }
    }
}

constexpr size_t GP_QI = 0, GP_P = 32768, GP_VT = 40960, GP_DEC = 106496, GP_KET = 107520;
__device__ __forceinline__ void gla_pre(CArgs* a, LAS unsigned char* lds, int vcu, int G, int l) {
    const int tid = opq_tid(), lane = tid & 63, wave = __builtin_amdgcn_readfirstlane(tid >> 6);
    LAS float* glow = (LAS float*)lds;
    LAS float* tot = (LAS float*)(lds + 4096);
    LAS float* BcL = (LAS float*)(lds + 8192);
    LAS bf16_t* QaL = (LAS bf16_t*)(lds + 73728);
    LAS bf16_t* KeL = (LAS bf16_t*)(lds + 107520);
    LAS bf16_t* KeTL = (LAS bf16_t*)(lds + 8192);
    LAS unsigned* VTLw = (LAS unsigned*)(lds + 45056);
    LAS bf16_t* VTL = (LAS bf16_t*)(lds + 45056);
    const bf16_t* PROJ = (const bf16_t*)(a->ws + WS_PROJ);
    const float* wgate = a->in[8] + (size_t)l * 16 * 1024; const float* bgate = a->in[9] + (size_t)l * 1024;
    for (int it = vcu; it < 1088; it += G) {
        int row0, h;
        if (it < 1024) { const int s = it >> 6, c = it & 63; h = s & 3; row0 = (s >> 2) * 4096 + c * 64; }
        else { const int s = it - 1024; h = s & 3; row0 = MP + (s >> 2) * 64; }
        const bf16_t* P = PROJ + (size_t)row0 * NIN;
        unsigned char* gp = a->ws + WS_GPRE + (size_t)it * GPRE_ITEM;
        bf16_t* Qi = (bf16_t*)(gp + GP_QI); bf16_t* Pg = (bf16_t*)(gp + GP_P); bf16_t* VT = (bf16_t*)(gp + GP_VT); float* dec = (float*)(gp + GP_DEC);
        __syncthreads();
        for (int i = tid; i < 1024; i += 512) glow[i] = bf2f(P[(size_t)(i >> 4) * NIN + 6144 + (i & 15)]);
        u32x4 qpre[4], kpre[4];
#pragma unroll
        for (int jj = 0; jj < 4; ++jj) { qpre[jj] = *(const u32x4*)(P + (size_t)(tid >> 3) * NIN + h * 256 + (tid & 7) * 32 + 8 * jj); kpre[jj] = *(const u32x4*)(P + (size_t)(tid >> 3) * NIN + 1024 + h * 256 + (tid & 7) * 32 + 8 * jj); }
        __syncthreads();
        {
            const int c = tid & 255, half = tid >> 8, col = h * 256 + c;
            float wg[16];
#pragma unroll
            for (int r = 0; r < 16; ++r) wg[r] = wgate[r * 1024 + col];
            const float bgv = bgate[col];
            float run = 0.f;
#pragma unroll 2
            for (int i = 0; i < 32; ++i) {
                const int t = half * 32 + i; float z = bgv;
#pragma unroll
                for (int r4 = 0; r4 < 4; ++r4) { const f32x4 gl = *(const LAS f32x4*)(glow + t * 16 + 4 * r4); z += gl[0] * wg[4 * r4] + gl[1] * wg[4 * r4 + 1] + gl[2] * wg[4 * r4 + 2] + gl[3] * wg[4 * r4 + 3]; }
                const float gk = -(fmaxf(-z, 0.f) + __logf(1.f + __expf(-fabsf(z)))) * 0.0625f;
                run += gk; BcL[t * 256 + c] = run;
            }
            tot[half * 256 + c] = run;
        }
        __syncthreads();
        {
            const int t = tid >> 3, c0 = (tid & 7) * 32;
#pragma unroll
            for (int jj = 0; jj < 4; ++jj) {
                const int c = c0 + 8 * jj;
                const u32x4 qv = qpre[jj], kv = kpre[jj];
                float bt[8], be[8];
                { const f32x4 b0 = *(const LAS f32x4*)(BcL + t * 256 + c), b1 = *(const LAS f32x4*)(BcL + t * 256 + c + 4);
                  const f32x4 t00 = *(const LAS f32x4*)(tot + c), t01 = *(const LAS f32x4*)(tot + c + 4), t10 = *(const LAS f32x4*)(tot + 256 + c), t11 = *(const LAS f32x4*)(tot + 256 + c + 4);
#pragma unroll
                  for (int e = 0; e < 4; ++e) { bt[e] = b0[e] + (t >= 32 ? t00[e] : 0.f); bt[4 + e] = b1[e] + (t >= 32 ? t01[e] : 0.f); be[e] = t00[e] + t10[e]; be[4 + e] = t01[e] + t11[e]; } }
                u32x4 oqi, oqa, oke;
#pragma unroll
                for (int e = 0; e < 4; ++e) {
                    const float q0 = bf2f(qv[e] & 0xffffu), q1 = bf2f(qv[e] >> 16), k0 = bf2f(kv[e] & 0xffffu), k1 = bf2f(kv[e] >> 16);
                    const float e0 = __expf(bt[2 * e]), e1 = __expf(bt[2 * e + 1]), d0 = __expf(bt[2 * e] - be[2 * e]), d1 = __expf(bt[2 * e + 1] - be[2 * e + 1]);
                    oqi[e] = pk2(q0 * e0, q1 * e1); oqa[e] = pk2(q0 * d0, q1 * d1); oke[e] = pk2(k0 / d0, k1 / d1);
                }
                *(u32x4*)(Qi + t * 256 + c) = oqi;
                *(LAS u32x4*)(QaL + t * 264 + c) = oqa; *(LAS u32x4*)(KeL + t * 264 + c) = oke;
            }
            if (tid < 256) dec[tid] = __expf(tot[tid] + tot[256 + tid]);
        }
        u32x4 vr0[4], vr1[4];
#pragma unroll
        for (int itr = 0; itr < 4; ++itr) { const int sp = itr * 8 + (lane >> 3), vc = wave * 8 + (lane & 7);
            vr0[itr] = *(const u32x4*)(P + (size_t)(2 * sp) * NIN + 2048 + h * 512 + vc * 8); vr1[itr] = *(const u32x4*)(P + (size_t)(2 * sp + 1) * NIN + 2048 + h * 512 + vc * 8); }
        __syncthreads();
        {
            const int mt = wave >> 1, ns0 = 2 * (wave & 1), lr = lane & 15, g = lane >> 4;
            f32x4 pacc[2] = {(f32x4){0.f, 0.f, 0.f, 0.f}, (f32x4){0.f, 0.f, 0.f, 0.f}};
#pragma unroll
            for (int st = 0; st < 8; ++st) {
                const bf16x8 av = *(const LAS bf16x8*)(QaL + (mt * 16 + lr) * 264 + 32 * st + 8 * g);
#pragma unroll
                for (int j = 0; j < 2; ++j) { const bf16x8 bv = *(const LAS bf16x8*)(KeL + ((ns0 + j) * 16 + lr) * 264 + 32 * st + 8 * g);
                    pacc[j] = __builtin_amdgcn_mfma_f32_16x16x32_bf16(av, bv, pacc[j], 0, 0, 0); }
            }
#pragma unroll
            for (int j = 0; j < 2; ++j)
#pragma unroll
                for (int i = 0; i < 4; ++i) { const int t = mt * 16 + 4 * g + i, s = (ns0 + j) * 16 + lr; Pg[t * 64 + s] = (bf16_t)f2bf(s <= t ? pacc[j][i] : 0.f); }
        }
        __syncthreads();
        {
            const int c = tid & 255, half = tid >> 8;
#pragma unroll 1
            for (int j = 0; j < 4; ++j) {
                unsigned w[4];
#pragma unroll
                for (int e = 0; e < 4; ++e) w[e] = (unsigned)KeL[(half * 32 + 8 * j + 2 * e) * 264 + c] | ((unsigned)KeL[(half * 32 + 8 * j + 2 * e + 1) * 264 + c] << 16);
                *(LAS u32x4*)(KeTL + c * 72 + half * 32 + j * 8) = (u32x4){w[0], w[1], w[2], w[3]};
            }
        }
        __syncthreads();
        {
            const int vc = wave * 8 + (lane & 7), sp0 = lane >> 3;
#pragma unroll
            for (int itr = 0; itr < 4; ++itr) {
                const int sp = itr * 8 + sp0;
                const u32x4 r0 = vr0[itr], r1 = vr1[itr];
#pragma unroll
                for (int e = 0; e < 4; ++e) { VTLw[(vc * 8 + 2 * e) * 36 + sp] = (r0[e] & 0xffffu) | (r1[e] << 16); VTLw[(vc * 8 + 2 * e + 1) * 36 + sp] = (r0[e] >> 16) | (r1[e] & 0xffff0000u); }
            }
        }
        __syncthreads();
        {
#pragma unroll
            for (int jj = 0; jj < 8; ++jj) { const int p = tid + 512 * jj, v = p >> 3, cc = p & 7; *(u32x4*)(VT + v * 64 + cc * 8) = *(const LAS u32x4*)(VTL + v * 72 + cc * 8); }
            bf16_t* KeTg = (bf16_t*)(gp + GP_KET);
#pragma unroll
            for (int jj = 0; jj < 4; ++jj) { const int p = tid + 512 * jj; *(u32x4*)(KeTg + (size_t)p * 8) = *(const LAS u32x4*)(KeTL + (p >> 3) * 72 + (p & 7) * 8); }
        }
    }
}

__device__ __forceinline__ void gla_x2_chain(CArgs* a, LAS unsigned char* lds, int item0, int nsteps, int vs, const float* sinit, float* sout) {
    const int tid = opq_tid(), lane = tid & 63, wave = __builtin_amdgcn_readfirstlane(tid >> 6), lr = lane & 15, g = lane >> 4;
    constexpr int BUF = 42496;
    f32x4 S[2][2];
#pragma unroll
    for (int kl = 0; kl < 2; ++kl)
#pragma unroll
        for (int vt = 0; vt < 2; ++vt)
#pragma unroll
            for (int i = 0; i < 4; ++i) S[kl][vt][i] = sinit ? sinit[(size_t)(16 * (2 * wave + kl) + 4 * g + i) * 512 + 32 * vs + 16 * vt + lr] : 0.f;
    u32x4 kregA[4], xregA, kregB[4], xregB;
#define X2_LOAD(KR, XR, c_) do { const unsigned char* gp_ = a->ws + WS_GPRE + (size_t)(item0 + (c_)) * GPRE_ITEM; \
        _Pragma("unroll") for (int j = 0; j < 4; ++j) KR[j] = *(const u32x4*)(gp_ + GP_KET + (size_t)(tid + 512 * j) * 16); \
        if (tid < 256) XR = *(const u32x4*)(gp_ + GP_VT + (size_t)(32 * vs) * 128 + (size_t)tid * 16); \
        else if (tid < 320) XR = *(const u32x4*)(gp_ + GP_DEC + (size_t)(tid - 256) * 16); } while (0)
#define X2_STAGE(KR, XR, b_) do { LAS unsigned char* bb_ = lds + (b_) * BUF; \
        _Pragma("unroll") for (int j = 0; j < 4; ++j) { const int p = tid + 512 * j; *(LAS u32x4*)(bb_ + ((p >> 3) * 72 + (p & 7) * 8) * 2) = KR[j]; } \
        if (tid < 256) *(LAS u32x4*)(bb_ + 36864 + ((tid >> 3) * 72 + (tid & 7) * 8) * 2) = XR; \
        else if (tid < 320) *(LAS u32x4*)(bb_ + 41472 + (tid - 256) * 16) = XR; } while (0)
#define X2_COMPUTE(c_) do { \
            LAS unsigned char* bb = lds + ((c_) % 3) * BUF; \
            const LAS bf16_t* KeTL = (const LAS bf16_t*)bb; const LAS bf16_t* VTL = (const LAS bf16_t*)(bb + 36864); const LAS float* decL = (const LAS float*)(bb + 41472); \
            bf16_t* stp = (bf16_t*)(a->ws + WS_UST) + (size_t)(item0 + (c_)) * 131072 + (size_t)(32 * vs + lr) * 256 + 4 * g; \
            bf16x8 vb[2][2]; \
            _Pragma("unroll") for (int vt = 0; vt < 2; ++vt) _Pragma("unroll") for (int st = 0; st < 2; ++st) vb[vt][st] = *(const LAS bf16x8*)(VTL + (16 * vt + lr) * 72 + 32 * st + 8 * g); \
            _Pragma("unroll") for (int kl = 0; kl < 2; ++kl) { const int kt = 2 * wave + kl; \
                const f32x4 d = *(const LAS f32x4*)(decL + 16 * kt + 4 * g); \
                const bf16x8 a0 = *(const LAS bf16x8*)(KeTL + (kt * 16 + lr) * 72 + 8 * g), a1 = *(const LAS bf16x8*)(KeTL + (kt * 16 + lr) * 72 + 32 + 8 * g); \
                _Pragma("unroll") for (int vt = 0; vt < 2; ++vt) { \
                    u32x2 w; w.x = pk2(S[kl][vt][0], S[kl][vt][1]); w.y = pk2(S[kl][vt][2], S[kl][vt][3]); *(u32x2*)(stp + (size_t)vt * 16 * 256 + 16 * kt) = w; \
                    S[kl][vt] = S[kl][vt] * d; \
                    S[kl][vt] = __builtin_amdgcn_mfma_f32_16x16x32_bf16(a0, vb[vt][0], S[kl][vt], 0, 0, 0); \
                    S[kl][vt] = __builtin_amdgcn_mfma_f32_16x16x32_bf16(a1, vb[vt][1], S[kl][vt], 0, 0, 0); } } } while (0)
    __syncthreads();
    X2_LOAD(kregA, xregA, 0);
    if (nsteps > 1) X2_LOAD(kregB, xregB, 1);
    X2_STAGE(kregA, xregA, 0);
    __syncthreads();
    for (int c = 0; c < nsteps; c += 2) {
        if (c + 2 < nsteps) X2_LOAD(kregA, xregA, c + 2);
        X2_COMPUTE(c);
        if (c + 1 < nsteps) X2_STAGE(kregB, xregB, (c + 1) % 3);
        LDS_BARRIER();
        if (c + 1 >= nsteps) break;
        if (c + 3 < nsteps) X2_LOAD(kregB, xregB, c + 3);
        X2_COMPUTE(c + 1);
        if (c + 2 < nsteps) X2_STAGE(kregA, xregA, (c + 2) % 3);
        LDS_BARRIER();
    }
#undef X2_LOAD
#undef X2_STAGE
#undef X2_COMPUTE
#pragma unroll
    for (int kl = 0; kl < 2; ++kl)
#pragma unroll
        for (int vt = 0; vt < 2; ++vt)
#pragma unroll
            for (int i = 0; i < 4; ++i) sout[(size_t)(16 * (2 * wave + kl) + 4 * g + i) * 512 + 32 * vs + 16 * vt + lr] = S[kl][vt][i];
}
__device__ __forceinline__ void gla_x2(CArgs* a, LAS unsigned char* lds, int vcu, int G, int l) {
    for (int jb = vcu; jb < 256 + 1024; jb += G) {
        const bool pr = jb < 256; const int si = pr ? jb : jb - 256, s = si >> 4, vs = si & 15, b = s >> 2, h = s & 3;
        const float* sinit = pr ? nullptr : a->in[2] + ((size_t)(l * 16 + b) * 4 + h) * 131072;
        float* sout = pr ? a->out + OUT_GLAP + ((size_t)(l * 4 + b) * 4 + h) * 131072 : a->out + OUT_GLAS + ((size_t)(l * 16 + b) * 4 + h) * 131072;
        gla_x2_chain(a, lds, pr ? s * 64 : 1024 + s, pr ? 64 : 1, vs, sinit, sout);
    }
}

__device__ __forceinline__ void gla_x3(CArgs* a, LAS unsigned char* lds, int vcu, int G, int l) {
    const int tid = opq_tid(), lane = tid & 63, wave = __builtin_amdgcn_readfirstlane(tid >> 6), lr = lane & 15, g = lane >> 4;
    LAS bf16_t* QiL = (LAS bf16_t*)lds;
    LAS bf16_t* PL = (LAS bf16_t*)(lds + 33792);
    LAS float* red = (LAS float*)(lds + 43008);
    LAS float* rsL = (LAS float*)(lds + 45056);
    const bf16_t* PROJ = (const bf16_t*)(a->ws + WS_PROJ); bf16_t* OG = (bf16_t*)(a->ws + WS_OG);
    const float* hn = a->in[10] + (size_t)l * 512;
    for (int it = vcu; it < 1088; it += G) {
        int row0, h;
        if (it < 1024) { const int s = it >> 6, c = it & 63; h = s & 3; row0 = (s >> 2) * 4096 + c * 64; }
        else { const int s = it - 1024; h = s & 3; row0 = MP + (s >> 2) * 64; }
        const unsigned char* gp = a->ws + WS_GPRE + (size_t)it * GPRE_ITEM;
        const bf16_t* Qi = (const bf16_t*)(gp + GP_QI); const bf16_t* Pg = (const bf16_t*)(gp + GP_P); const bf16_t* VT = (const bf16_t*)(gp + GP_VT);
        const bf16_t* ST = (const bf16_t*)(a->ws + WS_UST) + (size_t)it * 131072;
        __syncthreads();
#pragma unroll
        for (int j = 0; j < 4; ++j) { const int p = tid + 512 * j; *(LAS u32x4*)(QiL + (p >> 5) * 264 + (p & 31) * 8) = *(const u32x4*)(Qi + (size_t)p * 8); }
        *(LAS u32x4*)(PL + (tid >> 3) * 72 + (tid & 7) * 8) = *(const u32x4*)(Pg + (size_t)tid * 8);
        const bf16_t* vtp = VT + (size_t)(64 * wave + lr) * 64 + 8 * g; const bf16_t* stp = ST + (size_t)(64 * wave + lr) * 256 + 8 * g;
#define X3_A(st, mt) ((st) < 2 ? *(const bf16x8*)(vtp + (size_t)(mt) * 16 * 64 + 32 * (st)) : *(const bf16x8*)(stp + (size_t)(mt) * 16 * 256 + 32 * ((st) - 2)))
#define X3_B(st, nt) ((st) < 2 ? *(const LAS bf16x8*)(PL + (16 * (nt) + lr) * 72 + 32 * (st) + 8 * g) : *(const LAS bf16x8*)(QiL + (16 * (nt) + lr) * 264 + 32 * ((st) - 2) + 8 * g))
        bf16x8 A0[4][4], A1[3][4];
#pragma unroll
        for (int s_ = 0; s_ < 4; ++s_)
#pragma unroll
            for (int mt = 0; mt < 4; ++mt) A0[s_][mt] = X3_A(s_, mt);
#pragma unroll
        for (int s_ = 0; s_ < 3; ++s_)
#pragma unroll
            for (int mt = 0; mt < 4; ++mt) A1[s_][mt] = X3_A(4 + s_, mt);
        __syncthreads();
        f32x4 o[4][4];
#pragma unroll
        for (int mt = 0; mt < 4; ++mt)
#pragma unroll
            for (int nt = 0; nt < 4; ++nt) o[mt][nt] = (f32x4){0.f, 0.f, 0.f, 0.f};
#pragma unroll
        for (int s_ = 0; s_ < 4; ++s_) { bf16x8 bf[4];
#pragma unroll
            for (int nt = 0; nt < 4; ++nt) bf[nt] = X3_B(s_, nt);
#pragma unroll
            for (int mt = 0; mt < 4; ++mt)
#pragma unroll
                for (int nt = 0; nt < 4; ++nt) o[mt][nt] = __builtin_amdgcn_mfma_f32_16x16x32_bf16(A0[s_][mt], bf[nt], o[mt][nt], 0, 0, 0); }
#pragma unroll
        for (int s_ = 0; s_ < 3; ++s_)
#pragma unroll
            for (int mt = 0; mt < 4; ++mt) A0[s_][mt] = X3_A(7 + s_, mt);
#pragma unroll
        for (int s_ = 0; s_ < 3; ++s_) { bf16x8 bf[4];
#pragma unroll
            for (int nt = 0; nt < 4; ++nt) bf[nt] = X3_B(4 + s_, nt);
#pragma unroll
            for (int mt = 0; mt < 4; ++mt)
#pragma unroll
                for (int nt = 0; nt < 4; ++nt) o[mt][nt] = __builtin_amdgcn_mfma_f32_16x16x32_bf16(A1[s_][mt], bf[nt], o[mt][nt], 0, 0, 0); }
#pragma unroll
        for (int s_ = 0; s_ < 3; ++s_) { bf16x8 bf[4];
#pragma unroll
            for (int nt = 0; nt < 4; ++nt) bf[nt] = X3_B(7 + s_, nt);
#pragma unroll
            for (int mt = 0; mt < 4; ++mt)
#pragma unroll
                for (int nt = 0; nt < 4; ++nt) o[mt][nt] = __builtin_amdgcn_mfma_f32_16x16x32_bf16(A0[s_][mt], bf[nt], o[mt][nt], 0, 0, 0); }
#undef X3_A
#undef X3_B
#pragma unroll
        for (int nt = 0; nt < 4; ++nt) { float s = 0.f;
#pragma unroll
            for (int mt = 0; mt < 4; ++mt)
#pragma unroll
                for (int i = 0; i < 4; ++i) s += o[mt][nt][i] * o[mt][nt][i];
            s += __shfl_xor(s, 16); s += __shfl_xor(s, 32);
            if (g == 0) red[wave * 64 + 16 * nt + lr] = s; }
        __syncthreads();
        if (tid < 64) { float s = 0.f;
#pragma unroll
            for (int w = 0; w < 8; ++w) s += red[w * 64 + tid];
            rsL[tid] = rsqrtf(s * (1.f / 512.f) + EPS); }
        __syncthreads();
#pragma unroll
        for (int nt = 0; nt < 4; ++nt) {
            const int t = 16 * nt + lr; const float rs = rsL[t];
#pragma unroll
            for (int mt = 0; mt < 4; ++mt) {
                const int vv = 64 * wave + 16 * mt + 4 * g;
                const u32x2 rv = *(const u32x2*)(PROJ + (size_t)(row0 + t) * NIN + 4096 + h * 512 + vv);
                const f32x4 gn = *(const f32x4*)(hn + vv);
                const float r0 = bf2f(rv.x & 0xffffu), r1 = bf2f(rv.x >> 16), r2 = bf2f(rv.y & 0xffffu), r3 = bf2f(rv.y >> 16);
                u32x2 w; w.x = pk2(o[mt][nt][0] * rs * gn[0] * silu_f(r0), o[mt][nt][1] * rs * gn[1] * silu_f(r1)); w.y = pk2(o[mt][nt][2] * rs * gn[2] * silu_f(r2), o[mt][nt][3] * rs * gn[3] * silu_f(r3));
                *(u32x2*)(OG + (size_t)(row0 + t) * DM + h * 512 + vv) = w;
            }
        }
    }
}

__device__ __forceinline__ void attn_phase(CArgs* a, LAS unsigned char* lds, int vcu, int G, int j  ) {
    const int tid = opq_tid(), lane = tid & 63, wave = __builtin_amdgcn_readfirstlane(tid >> 6), l32 = lane & 31, hf = lane >> 5;
    LAS bf16_t* KL = (LAS bf16_t*)lds;
    LAS unsigned* VTLw = (LAS unsigned*)(lds + 17408);
    LAS float* RB = (LAS float*)(lds + 35840);
    const bf16_t* Q = (const bf16_t*)(a->ws + WS_Q); bf16_t* OA = (bf16_t*)(a->ws + WS_OG);
    const bf16_t* KVP = (const bf16_t*)(a->ws + WS_KVP); const bf16_t* KVS = (const bf16_t*)(a->ws + WS_KVS);
    const int gq = wave >> 1, tq = 32 * (wave & 1) + l32;
    __syncthreads();
    for (int i = tid; i < 16 * 513; i += 512) RB[i] = a->in[15][(size_t)j * 16 * 513 + i] * 1.4426950408889634f;
    const bool deal = (G == 256);
    const int nmine = deal ? (vcu < 64 ? 5 : 4) : (1088 - vcu + G - 1) / G;
    for (int ii = 0; ii < nmine; ++ii) {
        int it;
        if (!deal) it = vcu + ii * G;
        else {
            int f = -1, sb = 0, sc = 0, sn = 0;
            if (vcu < 64) { if (ii < 3) f = vcu * 3 + ii; else { const int t = vcu & 3, bn = vcu >> 2; sb = bn >> 2; sn = bn & 3; sc = (ii == 3) ? t : 7 - t; } }
            else f = 192 + (vcu - 64) * 4 + ii;
            if (f < 0) it = sb * 256 + sc * 4 + sn;
            else if (f < 896) { const int b = f / 224, rem = f % 224; it = b * 256 + (8 + (rem >> 2)) * 4 + (rem & 3); }
            else it = 1024 + (f - 896);
        }
        int qrow0, n, ntile; const bf16_t* kvb;
        if (it < 1024) { const int b = it >> 8, c = (it >> 2) & 63; n = it & 3; qrow0 = b * 4096 + c * 64; ntile = (c < 8 ? c : 8) + 1; kvb = KVP + (size_t)(b * 4096 + (c - (ntile - 1)) * 64) * 1024; }
        else { const int s = it - 1024, b = s >> 2; n = s & 3; qrow0 = MP + b * 64; ntile = 9; kvb = KVS + (size_t)b * 576 * 1024; }
        const int hq = n * 4 + gq;
        __syncthreads();
        bf16x8 qf[8];
#pragma unroll
        for (int st = 0; st < 8; ++st) qf[st] = *(const bf16x8*)(Q + (size_t)(qrow0 + tq) * DM + hq * 128 + 16 * st + 8 * hf);
        float mrun = -1e30f, lrun = 0.f;
        f32x16 oacc[4];
#pragma unroll
        for (int dt = 0; dt < 4; ++dt)
#pragma unroll
            for (int i = 0; i < 16; ++i) oacc[dt][i] = 0.f;
        const int pcc = tid & 15, psp = tid >> 4;
        u32x4 kp0, kp1, vp0, vp1;
        { const bf16_t* kt = kvb + n * 128 + (size_t)(2 * psp) * 1024 + pcc * 8; kp0 = *(const u32x4*)kt; kp1 = *(const u32x4*)(kt + 1024); vp0 = *(const u32x4*)(kt + 512); vp1 = *(const u32x4*)(kt + 1536); }
        for (int tl = 0; tl < ntile; ++tl) {
            const int d = ntile - 1 - tl;
            LDS_BARRIER();
            *(LAS u32x4*)(KL + (2 * psp) * 136 + pcc * 8) = kp0; *(LAS u32x4*)(KL + (2 * psp + 1) * 136 + pcc * 8) = kp1;
#pragma unroll
            for (int e = 0; e < 4; ++e) { VTLw[(pcc * 8 + 2 * e) * 36 + (psp ^ (2 * pcc))] = (vp0[e] & 0xffffu) | (vp1[e] << 16); VTLw[(pcc * 8 + 2 * e + 1) * 36 + (psp ^ (2 * pcc))] = (vp0[e] >> 16) | (vp1[e] & 0xffff0000u); }
            if (tl + 1 < ntile) { const bf16_t* kt = kvb + (size_t)(tl + 1) * 64 * 1024 + n * 128 + (size_t)(2 * psp) * 1024 + pcc * 8; kp0 = *(const u32x4*)kt; kp1 = *(const u32x4*)(kt + 1024); vp0 = *(const u32x4*)(kt + 512); vp1 = *(const u32x4*)(kt + 1536); }
            LDS_BARRIER();
            f32x16 sacc[2];
#pragma unroll
            for (int ms = 0; ms < 2; ++ms) {
#pragma unroll
                for (int i = 0; i < 16; ++i) sacc[ms][i] = 0.f;
#pragma unroll
                for (int st = 0; st < 8; ++st) { const bf16x8 av = *(const LAS bf16x8*)(KL + (32 * ms + l32) * 136 + 16 * st + 8 * hf); sacc[ms] = __builtin_amdgcn_mfma_f32_32x32x16_bf16(av, qf[st], sacc[ms], 0, 0, 0); }
            }
            if (d >= 5) { const float bc = RB[hq * 513 + 512];
#pragma unroll
                for (int ms = 0; ms < 2; ++ms)
#pragma unroll
                    for (int i = 0; i < 16; ++i) sacc[ms][i] += bc; }
            else {
#pragma unroll
                for (int ms = 0; ms < 2; ++ms)
#pragma unroll
                    for (int i = 0; i < 16; ++i) { const int s = 32 * ms + 8 * (i >> 2) + 4 * hf + (i & 3); int rel = 64 * d + tq - s; rel = rel > 256 ? 256 : rel; sacc[ms][i] += RB[hq * 513 + rel + 256]; }
            }
            float mx = sacc[0][0];
#pragma unroll
            for (int ms = 0; ms < 2; ++ms)
#pragma unroll
                for (int i = 0; i < 16; ++i) mx = fmaxf(mx, sacc[ms][i]);
            mx = fmaxf(mx, __shfl_xor(mx, 32));
            const float mnew = fmaxf(mrun, mx), alpha = __builtin_amdgcn_exp2f(mrun - mnew);
            float ls = 0.f;
#pragma unroll
            for (int ms = 0; ms < 2; ++ms)
#pragma unroll
                for (int i = 0; i < 16; ++i) { const float p = __builtin_amdgcn_exp2f(sacc[ms][i] - mnew); sacc[ms][i] = p; ls += p; }
            ls += __shfl_xor(ls, 32);
            lrun = lrun * alpha + ls; mrun = mnew;
            if (__any(alpha != 1.f)) {
#pragma unroll
                for (int dt = 0; dt < 4; ++dt)
#pragma unroll
                    for (int i = 0; i < 16; ++i) oacc[dt][i] *= alpha;
            }
#pragma unroll
            for (int st2 = 0; st2 < 4; ++st2) {
                const int ms = st2 >> 1, i0 = 8 * (st2 & 1);
                u32x4 pw; pw.x = pk2_sw(sacc[ms][i0], sacc[ms][i0 + 1]); pw.y = pk2_sw(sacc[ms][i0 + 2], sacc[ms][i0 + 3]); pw.z = pk2_sw(sacc[ms][i0 + 4], sacc[ms][i0 + 5]); pw.w = pk2_sw(sacc[ms][i0 + 6], sacc[ms][i0 + 7]);
                const bf16x8 pb = __builtin_bit_cast(bf16x8, pw);
#pragma unroll
                for (int dt = 0; dt < 4; ++dt) {
                    const int dd = 32 * dt + l32, sw = 2 * ((dd >> 3) & 15);
                    const u32x2 lo = *(const LAS u32x2*)(VTLw + dd * 36 + ((8 * st2 + 2 * hf) ^ sw)), hi = *(const LAS u32x2*)(VTLw + dd * 36 + ((8 * st2 + 2 * hf + 4) ^ sw));
                    const bf16x8 av = __builtin_bit_cast(bf16x8, (u32x4){lo.x, lo.y, hi.x, hi.y});
                    oacc[dt] = __builtin_amdgcn_mfma_f32_32x32x16_bf16(av, pb, oacc[dt], 0, 0, 0);
                }
            }
        }
        const float inv = 1.f / lrun;
        bf16_t* orow = OA + (size_t)(qrow0 + tq) * DM + hq * 128;
#pragma unroll
        for (int dt = 0; dt < 4; ++dt)
#pragma unroll
            for (int i4 = 0; i4 < 4; ++i4) { u32x2 w; w.x = pk2(oacc[dt][4 * i4] * inv, oacc[dt][4 * i4 + 1] * inv); w.y = pk2(oacc[dt][4 * i4 + 2] * inv, oacc[dt][4 * i4 + 3] * inv);
                *(u32x2*)(orow + 32 * dt + 8 * i4 + 4 * hf) = w; }
    }
}

__global__ void __launch_bounds__(512) yoco_fwd(Args a_unused) {
    extern __shared__ __attribute__((aligned(16))) unsigned char lds_raw[];
    LAS unsigned char* lds = (LAS unsigned char*)lds_raw;
    cg::grid_group grid = cg::this_grid();
    const int G = gridDim.x, bx = blockIdx.x;
    const int vcu = (G % 8 == 0) ? (bx % 8) * (G / 8) + bx / 8 : bx;
    const int lo = get_args()->ph_lo, hi = get_args()->ph_hi;
    int ph = 0;
    if (threadIdx.x < 16) ((LAS unsigned*)(lds + LDS_BARST))[threadIdx.x] = 0u;
    __syncthreads();
    XcdBarrier bar = xcd_barrier_post((unsigned*)(get_args()->ws + WS_CTL), (volatile LAS unsigned*)(lds + LDS_BARST));
#define RUN (ph >= lo && ph < hi)
#ifndef R_SYNC
#define R_SYNC 1
#endif
#ifndef R_P0
#define R_P0 1
#endif
#ifndef R_PRE
#define R_PRE 1
#endif
#ifndef R_X3
#define R_X3 1
#endif
#ifndef R_X2
#define R_X2 1
#endif
#ifndef R_ATT
#define R_ATT 1
#endif
#ifndef R_CONV
#define R_CONV 1
#endif
#define GSYNC() do { if (lo < 0) grid.sync(); else xcd_barrier(bar); } while (0)
#define SEAM() do { ++ph; if (ph > lo && ph < hi) { for (int r_ = 0; r_ < R_SYNC; ++r_) GSYNC(); } } while (0)
#ifndef R_GEMM
#define R_GEMM 1
#endif
#define REP(n, call) do { for (int q_ = 0; q_ < (n); ++q_) { call; if (q_ + 1 < (n)) xcd_barrier(bar); } } while (0)

    if (RUN) REP(R_P0, p0_prologue(get_args(), lds, vcu, G));
    SEAM();
#pragma unroll 1
    for (int l = 0; l < 4; ++l) {
        if (RUN) {
            CArgs* a = get_args(); unsigned char* ws = a->ws; const bf16_t* H = (const bf16_t*)(ws + WS_XB);
            pg8::Gemm g; pg8::EpiGen E{};
            if (l < 2) { g = pg8::Gemm{H, (const bf16_t*)(ws + WS_WIN) + (size_t)l * NIN * 2048, M, NIN, 2048}; E.O = (bf16_t*)(ws + WS_PROJ); E.ldc = NIN; E.kvq = 0; }
            else if (l == 2) { g = pg8::Gemm{H, (const bf16_t*)(ws + WS_WKVQ), M, 3072, 2048}; E.O = (bf16_t*)(ws + WS_Q); E.ldc = DM; E.kvq = 1; }
            else { g = pg8::Gemm{H, (const bf16_t*)(ws + WS_WQ3), M, 2048, 2048}; E.O = (bf16_t*)(ws + WS_Q); E.ldc = DM; E.kvq = 0; }
            if (l == 2) kvs_cache_convert(a, vcu, G);
            E.rs = (const float*)(ws + WS_RS); E.KVP = (bf16_t*)(ws + WS_KVP); E.KVS = (bf16_t*)(ws + WS_KVS); E.okp = a->out + OUT_KP; E.ovp = a->out + OUT_VP; E.oks = a->out + OUT_KS; E.ovs = a->out + OUT_VS;
            pg8::StaticOrder S; S.init(g.M, g.N, G, bx);
            REP(R_GEMM, (pg8::gemm_phase<pg8::EpiGen, pg8::StaticOrder, true, true>(lds, g, S, E)));
            if (l < 2) convert_in_phase(a, lds, G, bx, l, 164, 0, 348); else if (l == 2) convert_in_phase(a, lds, G, bx, l, 48, 0, 553);
        }
        SEAM();
        if (l < 2) {
            if (RUN) REP(R_PRE, gla_pre(get_args(), lds, vcu, G, l));
            SEAM();
            if (RUN) REP(R_X2, gla_x2(get_args(), lds, vcu, G, l));
            SEAM();
            if (RUN) REP(R_X3, gla_x3(get_args(), lds, vcu, G, l));
            SEAM();
        } else {
            if (RUN) REP(R_ATT, attn_phase(get_args(), lds, vcu, G, l - 2));
            SEAM();
        }
        if (RUN) {
            unsigned char* ws = get_args()->ws; bf16_t* MF = (bf16_t*)(ws + WS_MF);
            const bf16_t* W = l < 2 ? (const bf16_t*)(ws + WS_GWO) + (size_t)l * 2048 * 2048 : (const bf16_t*)(ws + WS_AWO) + (size_t)(l - 2) * 2048 * 2048;
            pg8::Gemm g{(const bf16_t*)(ws + WS_OG), W, M, 2048, 2048}; pg8::EpiF32 E{MF, DM, (float*)(ws + WS_MFP), MP, (size_t)MS * DM, 0};
            pg8::TailSplitOrder S; S.init(MP / 256, MS / 256, 2048, 8, 2048, G, bx);
            REP(R_GEMM, (pg8::gemm_phase<pg8::EpiF32, pg8::TailSplitOrder, true, true>(lds, g, S, E)));
        }
        SEAM();
        if (RUN) norm_pass(get_args(), lds, vcu, G, get_args()->in[6] + (l * 4 + 1) * 2048, false, true, 8);
        SEAM();
        if (RUN) {
            unsigned char* ws = get_args()->ws; const bf16_t* H = (const bf16_t*)(ws + WS_XB);
            CArgs* a = get_args();
            pg8::Gemm g{H, (const bf16_t*)(ws + WS_WUP) + (size_t)l * NUP * 2048, M, NUP, 2048};
            pg8::EpiUp E{(bf16_t*)(ws + WS_HF), a->in[18] + (size_t)l * 3 * DFF, a->in[19] + (size_t)l * DFF, (float*)(ws + WS_GT), (float*)(ws + WS_GH), (float*)(ws + WS_VH), (const float*)(ws + WS_RS), 0, lds};
            pg8::StaticOrder S; S.init(g.M, g.N, G, bx);
            REP(R_GEMM, (pg8::gemm_phase<pg8::EpiUp, pg8::StaticOrder, true, true>(lds, g, S, E)));
            if (l < 2) convert_in_phase(a, lds, G, bx, l, 176, 348, 649); else convert_in_phase(a, lds, G, bx, l, 176, 553, 764);
        }
        SEAM();
        if (RUN) REP(R_CONV, conv_pass(get_args(), vcu, G, l));
        SEAM();
        if (RUN) {
            unsigned char* ws = get_args()->ws; bf16_t* MF = (bf16_t*)(ws + WS_MF);
            pg8::Gemm g{(const bf16_t*)(ws + WS_HF), (const bf16_t*)(ws + WS_WDN) + (size_t)l * 2048 * DFF, M, 2048, DFF}; pg8::EpiF32 E{MF, DM, (float*)(ws + WS_MFP), MP, (size_t)MS * DM, 0};
            pg8::TailSplitOrder S; S.init(MP / 256, MS / 256, 2048, 4, DFF, G, bx);
            REP(R_GEMM, (pg8::gemm_phase<pg8::EpiF32, pg8::TailSplitOrder, true, true>(lds, g, S, E)));
            if (l < 2) convert_in_phase(get_args(), lds, G, bx, l, 128, 649, 1024); else convert_in_phase(get_args(), lds, G, bx, l, 128, 764, 1024);
        }
        SEAM();
        if (RUN) norm_pass(get_args(), lds, vcu, G, get_args()->in[6] + (l * 4 + 3) * 2048, false, l < 3, 4);
        SEAM();
    }
#undef RUN
#undef SEAM
}

extern "C" void kernel_launch(void* const* d_in, const int* in_sizes, int n_in, void* d_out, int out_size, void* d_ws, size_t ws_size, hipStream_t stream) {
    static int grid = 0;
    if (grid == 0) {
        if (n_in != 21 || ws_size < WS_END6) { fprintf(stderr, "kernel_launch: unexpected n_in %d / ws_size %zu (need %zu)\n", n_in, ws_size, (size_t)WS_END6); grid = -1; return; }
        int dev = 0, cus = 0, per_cu = 0;
        hipGetDevice(&dev); hipDeviceGetAttribute(&cus, hipDeviceAttributeMultiprocessorCount, dev);
        hipFuncSetAttribute((const void*)yoco_fwd, hipFuncAttributeMaxDynamicSharedMemorySize, LDS_BYTES);
        hipOccupancyMaxActiveBlocksPerMultiprocessor(&per_cu, (const void*)yoco_fwd, 512, LDS_BYTES);
        if (per_cu < 1) { fprintf(stderr, "kernel_launch: occupancy query says %d blocks per CU\n", per_cu); per_cu = 1; }
        (void)hipGetLastError();
        grid = cus * per_cu;
    }
    if (grid < 0) return;
    if (hipMemsetAsync((char*)d_ws + WS_CTL, 0, CTL_BYTES, stream) != hipSuccess) { fprintf(stderr, "memset failed\n"); return; }
    Args a{};
    for (int i = 0; i < 21; ++i) a.in[i] = (const float*)d_in[i];
    a.out = (float*)d_out; a.ws = (unsigned char*)d_ws; a.ph_lo = 0; a.ph_hi = 1000;
    void* args[] = {&a};
    hipError_t e = hipLaunchCooperativeKernel((const void*)yoco_fwd, dim3(grid), dim3(512), args, LDS_BYTES, stream);
    if (e != hipSuccess) fprintf(stderr, "cooperative launch failed: %s (grid %d)\n", hipGetErrorString(e), grid);
}
```

```cpp
#include <hip/hip_runtime.h>
#include <hip/hip_cooperative_groups.h>
#include <cstdio>
#include <cstdint>
#define LAS __attribute__((address_space(3)))
__device__ __forceinline__ int opq_tid() { int t = threadIdx.x; asm volatile("" : "+v"(t)); return t; }
namespace pg8 {
#define PG8_LAS __attribute__((address_space(3)))
typedef unsigned short bf16_t;
typedef short bf16x8 __attribute__((ext_vector_type(8)));
typedef float f32x4 __attribute__((ext_vector_type(4)));
typedef unsigned u32x4 __attribute__((ext_vector_type(4)));
constexpr int BM = 256, BK = 64, HALF = 128, HTB = HALF * BK * 2  , STAGE_BYTES = 8 * HTB, NXCD = 8, WGM = 8;

__host__ __device__ __forceinline__ int lds_byte(int r, int c) { const int st = (r >> 4) * 2 + (c >> 5), rr = r & 15, cc = c & 31, ob = rr * 64 + cc * 2; return st * 1024 + (ob ^ (((ob >> 9) & 1) << 5)); }
__host__ __device__ __forceinline__ void stage_rc(int b, int& R, int& C) { const int st = b / 1024, sb = b % 1024, swz = sb ^ (((sb >> 9) & 1) << 5); R = (st >> 1) * 16 + swz / 64; C = (st & 1) * 32 + (swz % 64) / 2; }
__host__ __device__ __forceinline__ int perm32(int rho) { const int n = rho >> 4, i = rho & 15; return 8 * (i >> 2) + 4 * n + (i & 3); }

struct Unit { int pm, pn, ks, nt; };
struct Gemm { const bf16_t* A; const bf16_t* Bt; int M, N, K; };

struct StaticOrder {
    int nM, nN, nwg, G, c;
    __host__ __device__ void init(int M, int N, int G_, int c_) { nM = M / BM; nN = N / BM; nwg = nM * nN; G = G_; c = c_; }
    __host__ __device__ bool next(int i, Unit& u) const {
        const long L = (long)i * G + c; if (L >= nwg) return false;
        int wgid = (int)L; { const int q = nwg / NXCD, r = nwg % NXCD, xcd = wgid % NXCD, off = wgid / NXCD; wgid = (xcd < r ? xcd * (q + 1) : r * (q + 1) + (xcd - r) * q) + off; }
        const int nig = WGM * nN, gid = wgid / nig, fm = gid * WGM, gsz = (nM - fm) < WGM ? (nM - fm) : WGM;
        u.pm = fm + ((wgid % nig) % gsz); u.pn = (wgid % nig) / gsz; u.ks = 0; u.nt = 0; return true;
    }
    __device__ __forceinline__ void a_ready(const Unit&) const {}
    __device__ __forceinline__ void done(const Unit&) const {}
};
struct TailSplitOrder {
    int nMf, nMt, nN, nfull, S, ntk, G, c;
    __host__ __device__ void init(int nMf_, int nMt_, int N, int S_, int K, int G_, int c_) { nMf = nMf_; nMt = nMt_; nN = N / BM; nfull = nMf * nN; S = S_; ntk = K / BK / S_; G = G_; c = c_; }
    __host__ __device__ bool next(int i, Unit& u) const {
        const long L = (long)i * G + c;
        const bool full = L < nfull;
        const int r = (int)(L - nfull);
        if (!full && r >= nMt * nN * S) return false;
        int wgid = full ? (int)L : 0; { const int q = nfull / NXCD, rr = nfull % NXCD, xcd = wgid % NXCD, off = wgid / NXCD; wgid = (xcd < rr ? xcd * (q + 1) : rr * (q + 1) + (xcd - rr) * q) + off; }
        const int nig = WGM * nN, gid = wgid / nig, fm = gid * WGM, gsz = (nMf - fm) < WGM ? (nMf - fm) : WGM;
        const int fpm = fm + ((wgid % nig) % gsz), fpn = (wgid % nig) / gsz;
        const int rc = full ? 0 : r, tile = rc / S;
        const int pm_ = full ? fpm : nMf + tile % nMt, pn_ = full ? fpn : tile / nMt, ks_ = full ? 0 : rc % S, nt_ = full ? 0 : ntk;
        u.pm = pm_; u.pn = pn_; u.ks = ks_; u.nt = nt_; return true;
    }
    __device__ __forceinline__ void a_ready(const Unit&) const {}
    __device__ __forceinline__ void done(const Unit&) const {}
};
typedef unsigned u32x2v __attribute__((ext_vector_type(2)));
typedef float f32x2c_t __attribute__((ext_vector_type(2))); typedef __bf16 bf16x2c_t __attribute__((ext_vector_type(2)));
__device__ __forceinline__ unsigned cvt_pk_bf16(float lo, float hi) { f32x2c_t v = {lo, hi}; bf16x2c_t b = __builtin_convertvector(v, bf16x2c_t); return __builtin_bit_cast(unsigned, b); }

struct EpiGen {
    static constexpr bool PERM = true, AFTER_DRAIN = false;
    bf16_t* O; int ldc; int kvq; bf16_t* KVP; bf16_t* KVS; float* okp; float* ovp; float* oks; float* ovs; const float* rs;
    int par; PG8_LAS unsigned char* ldsb;
    __device__ __forceinline__ void prefetch(const Unit& u, int p, int wid, int lane, PG8_LAS unsigned char* lds) {
        ldsb = lds;
        if (wid < 4) __builtin_amdgcn_global_load_lds((const unsigned*)(rs + (size_t)u.pm * BM + wid * 64 + lane), (PG8_LAS unsigned*)(lds + 131072 + p * 1024 + wid * 256), 4, 0, 0);
    }
    __device__ __forceinline__ void operator()(const f32x4 (&acc)[2][2][4][2], const Unit& u, int wr, int wc, int fr, int fq) const {
        const int row0 = u.pm * BM + wr * 64 + fr;
        if (!kvq || u.pn >= 4) {
            const int col0 = u.pn * BM - (kvq ? 1024 : 0) + wc * 32 + 8 * fq;
#pragma unroll
            for (int ai = 0; ai < 2; ++ai)
#pragma unroll
                for (int m = 0; m < 4; ++m) { bf16_t* rowp = O + (size_t)(row0 + ai * HALF + m * 16) * ldc + col0; const float rr = ((const PG8_LAS float*)(ldsb + 131072 + par * 1024))[wr * 64 + fr + ai * HALF + m * 16];
#pragma unroll
                    for (int bj = 0; bj < 2; ++bj) { const f32x4 v0 = acc[ai][bj][m][0] * rr, v1 = acc[ai][bj][m][1] * rr;
                        u32x4 w; w.x = cvt_pk_bf16(v0[0], v0[1]); w.y = cvt_pk_bf16(v0[2], v0[3]); w.z = cvt_pk_bf16(v1[0], v1[1]); w.w = cvt_pk_bf16(v1[2], v1[3]);
                        *(u32x4*)(rowp + bj * HALF) = w; } }
        } else {
            const int col0 = u.pn * BM + wc * 32 + 8 * fq;
            const bool isv = col0 >= 512; const int oc = isv ? col0 - 512 : col0;
#pragma unroll
            for (int ai = 0; ai < 2; ++ai)
#pragma unroll
                for (int m = 0; m < 4; ++m) {
                    const int r = row0 + ai * HALF + m * 16; const float rr = ((const PG8_LAS float*)(ldsb + 131072 + par * 1024))[wr * 64 + fr + ai * HALF + m * 16];
                    bf16_t* rowp; float* fo = nullptr;
                    if (r < 16384) { rowp = KVP + (size_t)r * 1024 + col0; const int t = r & 4095;
                        if (t >= 3584) fo = (isv ? ovp : okp) + ((size_t)(r >> 12) * 512 + (t - 3584)) * 512 + oc; }
                    else { const int rs = r - 16384, b = rs >> 6, t = rs & 63; rowp = KVS + ((size_t)b * 576 + 512 + t) * 1024 + col0; fo = (isv ? ovs : oks) + (size_t)rs * 512 + oc; }
#pragma unroll
                    for (int bj = 0; bj < 2; ++bj) { const f32x4 v0 = acc[ai][bj][m][0] * rr, v1 = acc[ai][bj][m][1] * rr;
                        u32x4 w; w.x = cvt_pk_bf16(v0[0], v0[1]); w.y = cvt_pk_bf16(v0[2], v0[3]); w.z = cvt_pk_bf16(v1[0], v1[1]); w.w = cvt_pk_bf16(v1[2], v1[3]);
                        *(u32x4*)(rowp + bj * HALF) = w;
                        if (fo) { *(f32x4*)(fo + bj * HALF) = v0; *(f32x4*)(fo + bj * HALF + 4) = v1; } } }
        }
    }
};
struct EpiF32 {
    static constexpr bool PERM = false, AFTER_DRAIN = false;
    bf16_t* O; int ldc; float* P; int prow0; size_t pstride;
    int par; __device__ __forceinline__ void prefetch(const Unit&, int, int, int, PG8_LAS unsigned char*) {}
    __device__ __forceinline__ void operator()(const f32x4 (&acc)[2][2][4][2], const Unit& u, int wr, int wc, int fr, int fq) const {
        const int row0 = u.pm * BM + wr * 64 + fr, col0 = u.pn * BM + wc * 32 + 4 * fq;
        if (u.nt) {
            float* base = P + (size_t)u.ks * pstride - (size_t)prow0 * ldc;
#pragma unroll
            for (int ai = 0; ai < 2; ++ai)
#pragma unroll
                for (int m = 0; m < 4; ++m) { float* rowp = base + (size_t)(row0 + ai * HALF + m * 16) * ldc + col0;
#pragma unroll
                    for (int bj = 0; bj < 2; ++bj)
#pragma unroll
                        for (int n = 0; n < 2; ++n) *(f32x4*)(rowp + bj * HALF + n * 16) = acc[ai][bj][m][n]; }
        } else {
#pragma unroll
            for (int ai = 0; ai < 2; ++ai)
#pragma unroll
                for (int m = 0; m < 4; ++m) { bf16_t* rowp = O + (size_t)(row0 + ai * HALF + m * 16) * ldc + col0;
#pragma unroll
                    for (int bj = 0; bj < 2; ++bj)
#pragma unroll
                        for (int n = 0; n < 2; ++n) { const f32x4 v = acc[ai][bj][m][n]; u32x2v w; w.x = cvt_pk_bf16(v[0], v[1]); w.y = cvt_pk_bf16(v[2], v[3]); *(u32x2v*)(rowp + bj * HALF + n * 16) = w; } }
        }
    }
};

struct EpiUp {
    static constexpr bool PERM = true, AFTER_DRAIN = false;
    bf16_t* HF; const float* cw; const float* cb; float* GT; float* GH; float* VH; const float* rs;
    int par; PG8_LAS unsigned char* ldsb;
    __device__ __forceinline__ void prefetch(const Unit& u, int p, int wid, int lane, PG8_LAS unsigned char* lds) {
        ldsb = lds;
        if (wid < 4) __builtin_amdgcn_global_load_lds((const unsigned*)(rs + (size_t)u.pm * BM + wid * 64 + lane), (PG8_LAS unsigned*)(lds + 131072 + p * 1024 + wid * 256), 4, 0, 0);
        const int arr = wid >> 1, hf = wid & 1;
        const float* src = (arr < 3 ? cw + (size_t)arr * 5632 : cb) + 128 * u.pn + hf * 64 + lane;
        __builtin_amdgcn_global_load_lds((const unsigned*)src, (PG8_LAS unsigned*)(lds + 133120 + p * 2048 + arr * 512 + hf * 256), 4, 0, 0);
    }
    __device__ __forceinline__ void operator()(const f32x4 (&acc)[2][2][4][2], const Unit& u, int wr, int wc, int fr, int fq) const {
        const int lane = fr | (fq << 4);
        const int src1 = (lane & 48) | ((fr + 15) & 15), src2 = (lane & 48) | ((fr + 14) & 15);
        const int jb = 128 * u.pn + 32 * wc + 8 * fq;
#pragma unroll
        for (int n = 0; n < 2; ++n) {
            const int j0 = jb + 4 * n;
            const PG8_LAS float* cwl = (const PG8_LAS float*)(ldsb + 133120 + par * 2048) + 32 * wc + 8 * fq + 4 * n;
            const f32x4 w0 = *(const PG8_LAS f32x4*)cwl, w1 = *(const PG8_LAS f32x4*)(cwl + 128), w2 = *(const PG8_LAS f32x4*)(cwl + 256), bb = *(const PG8_LAS f32x4*)(cwl + 384);
#pragma unroll
            for (int ai = 0; ai < 2; ++ai) {
                f32x4 p1 = (f32x4){0.f, 0.f, 0.f, 0.f}, p2 = p1;
#pragma unroll
                for (int m = 0; m < 4; ++m) {
                    const float rr = ((const PG8_LAS float*)(ldsb + 131072 + par * 1024))[ai * HALF + wr * 64 + m * 16 + fr];
                    const f32x4 G = acc[ai][0][m][n] * rr, V = acc[ai][1][m][n] * rr;
                    f32x4 r1, r2;
#pragma unroll
                    for (int e = 0; e < 4; ++e) { r1[e] = __shfl(G[e], src1); r2[e] = __shfl(G[e], src2); }
                    const f32x4 g1 = fr >= 1 ? r1 : p1, g2 = fr >= 2 ? r2 : p2;
                    const f32x4 c = bb + w0 * g2 + w1 * g1 + w2 * G;
                    f32x4 h;
#pragma unroll
                    for (int e = 0; e < 4; ++e) h[e] = c[e] * __builtin_amdgcn_rcpf(1.f + __expf(-c[e])) * V[e];
                    const int row = u.pm * BM + ai * HALF + wr * 64 + m * 16 + fr;
                    if (m == 0 && fr < 2) { const size_t o = ((size_t)(row >> 6) * 2 + fr) * 5632 + j0; *(f32x4*)(GH + o) = G; *(f32x4*)(VH + o) = V; }
                    else { u32x2v w; w.x = cvt_pk_bf16(h[0], h[1]); w.y = cvt_pk_bf16(h[2], h[3]); *(u32x2v*)(HF + (size_t)row * 5632 + j0) = w; }
                    if (m == 3 && fr >= 14) { const size_t o = ((size_t)(row >> 6) * 2 + (fr - 14)) * 5632 + j0; *(f32x4*)(GT + o) = G; }
                    p1 = r1; p2 = r2;
                }
            }
        }
    }
};
template <class Epi, class Sched, bool ALIGN_EPI = false, bool SP2 = false>
__device__ __forceinline__ void gemm_phase(PG8_LAS unsigned char* lds, const Gemm g, const Sched& S, const Epi& E_) {
    Epi E = E_;
    const int tid = opq_tid(), wid = __builtin_amdgcn_readfirstlane(tid >> 6), lane = tid & 63, wr = wid >> 2, wc = wid & 3, fr = lane & 15, fq = lane >> 4;
    const int K = g.K, nt = K / BK;
    unsigned voffA[2], voffB[2];
#pragma unroll
    for (int i = 0; i < 2; ++i) { int R, C; stage_rc(tid * 16 + i * 8192, R, C); const int Rb = Epi::PERM ? ((R & ~31) + perm32(R & 31)) : R;
        voffA[i] = (unsigned)(R * K + C) * 2u; voffB[i] = (unsigned)(Rb * K + C) * 2u; }
    const size_t kstep = (size_t)(BK * 2);
    const size_t hstep = (size_t)HALF * K * 2;
    const size_t tstep = 2 * hstep;
    const unsigned ldsw = (unsigned)wid * 1024u;
    const int aoff = lds_byte(wr * 64 + fr, fq * 8), boff = lds_byte(wc * 32 + fr, fq * 8);
#define PG8_SA(b, h) (((b) * 2 + (h)) * HTB)
#define PG8_SB(b, h) ((4 + (b) * 2 + (h)) * HTB)
#define PG8_STAGE(bufoff, gbase, voff) do { _Pragma("unroll") for (int _i = 0; _i < 2; ++_i) \
        __builtin_amdgcn_global_load_lds((const unsigned*)((const char*)(gbase) + (voff)[_i]), (PG8_LAS unsigned*)(lds + (bufoff) + ldsw + _i * 8192), 16, 0, 0); } while (0)
#define PG8_LDA(dst, b, h) do { _Pragma("unroll") for (int m = 0; m < 4; ++m) _Pragma("unroll") for (int k = 0; k < 2; ++k) dst[m][k] = *(const PG8_LAS bf16x8*)(lds + PG8_SA(b, h) + aoff + m * 2048 + k * 1024); } while (0)
#define PG8_LDB(dst, b, h) do { _Pragma("unroll") for (int n = 0; n < 2; ++n) _Pragma("unroll") for (int k = 0; k < 2; ++k) dst[n][k] = *(const PG8_LAS bf16x8*)(lds + PG8_SB(b, h) + boff + n * 2048 + k * 1024); } while (0)
#define PG8_MMA(ai, bj, At, Bt) do { __builtin_amdgcn_s_setprio(1); _Pragma("unroll") for (int m = 0; m < 4; ++m) _Pragma("unroll") for (int n = 0; n < 2; ++n) _Pragma("unroll") for (int k = 0; k < 2; ++k) \
        acc[ai][bj][m][n] = __builtin_amdgcn_mfma_f32_16x16x32_bf16(Bt[n][k], At[m][k], acc[ai][bj][m][n], 0, 0, 0); __builtin_amdgcn_s_setprio(0); } while (0)
#define PG8_WAIT_V(n) asm volatile("s_waitcnt vmcnt(" #n ")" ::: "memory")
#define PG8_WAIT_L(n) asm volatile("s_waitcnt lgkmcnt(" #n ")" ::: "memory")
#define PG8_BAR __builtin_amdgcn_s_barrier()
#define PG8_SCHED __builtin_amdgcn_sched_barrier(0)
    Unit cur, nxt; int ui = 0;
    if (!S.next(0, cur)) return;
    f32x4 acc[2][2][4][2];
#pragma unroll
    for (int a = 0; a < 2; ++a)
#pragma unroll
        for (int b = 0; b < 2; ++b)
#pragma unroll
            for (int m = 0; m < 4; ++m)
#pragma unroll
                for (int n = 0; n < 2; ++n) acc[a][b][m][n] = (f32x4){0.f, 0.f, 0.f, 0.f};
    bf16x8 At[4][2], B0[2][2], B1[2][2];
    const char* cA = (const char*)g.A + (size_t)cur.pm * tstep + (size_t)cur.ks * cur.nt * (BK * 2); const char* cB = (const char*)g.Bt + (size_t)cur.pn * tstep + (size_t)cur.ks * cur.nt * (BK * 2);
    S.a_ready(cur);
    E.prefetch(cur, 0, wid, lane, lds);
    if constexpr (SP2) {
        PG8_STAGE(PG8_SB(0, 0), cB, voffB); PG8_STAGE(PG8_SB(0, 1), cB + hstep, voffB); PG8_STAGE(PG8_SA(0, 0), cA, voffA); PG8_STAGE(PG8_SA(0, 1), cA + hstep, voffA);
        if (wr == 1) PG8_BAR;
        PG8_WAIT_V(2); PG8_BAR;
        PG8_STAGE(PG8_SB(1, 0), cB + kstep, voffB); PG8_STAGE(PG8_SA(1, 0), cA + kstep, voffA); PG8_STAGE(PG8_SB(1, 1), cB + hstep + kstep, voffB);
        PG8_WAIT_V(6); PG8_BAR;
    } else {
        PG8_STAGE(PG8_SB(0, 0), cB, voffB); PG8_STAGE(PG8_SA(0, 0), cA, voffA); PG8_STAGE(PG8_SB(0, 1), cB + hstep, voffB); PG8_STAGE(PG8_SA(0, 1), cA + hstep, voffA);
        if (wr == 1) PG8_BAR;
        PG8_WAIT_V(4); PG8_BAR;
        PG8_STAGE(PG8_SB(1, 0), cB + kstep, voffB); PG8_STAGE(PG8_SA(1, 0), cA + kstep, voffA); PG8_STAGE(PG8_SB(1, 1), cB + hstep + kstep, voffB);
        PG8_WAIT_V(6); PG8_BAR;
    }
    for (;;) {
        const bool has_next = S.next(ui + 1, nxt);
        const char* nA = has_next ? (const char*)g.A + (size_t)nxt.pm * tstep + (size_t)nxt.ks * nxt.nt * (BK * 2) : cA; const char* nB = has_next ? (const char*)g.Bt + (size_t)nxt.pn * tstep + (size_t)nxt.ks * nxt.nt * (BK * 2) : cB;
        const int ntu = cur.nt ? cur.nt : nt;
        for (int t = 0; t < ntu; t += 2) {
            const bool last = (t == ntu - 2);
            const char* a1 = cA + (size_t)(t + 1) * kstep;
            const char* a2 = last ? nA : cA + (size_t)(t + 2) * kstep; const char* b2 = last ? nB : cB + (size_t)(t + 2) * kstep;
            const char* a3 = a2 + kstep; const char* b3 = b2 + kstep;
            if (last && has_next) S.a_ready(nxt);
            if constexpr (SP2) {
            PG8_LDB(B0, 0, 0); PG8_LDB(B1, 0, 1); PG8_SCHED; PG8_LDA(At, 0, 0); PG8_STAGE(PG8_SA(1, 1), a1 + hstep, voffA);
            PG8_WAIT_V(8); PG8_WAIT_L(0); PG8_BAR; PG8_MMA(0, 0, At, B0); PG8_MMA(0, 1, At, B1); PG8_BAR; PG8_SCHED;
            PG8_LDA(At, 0, 1); PG8_STAGE(PG8_SB(0, 0), b2, voffB); PG8_STAGE(PG8_SB(0, 1), b2 + hstep, voffB); PG8_STAGE(PG8_SA(0, 0), a2, voffA);
            PG8_WAIT_V(8); PG8_WAIT_L(0); PG8_BAR; PG8_MMA(1, 0, At, B0); PG8_MMA(1, 1, At, B1); PG8_BAR; PG8_SCHED;
            PG8_LDB(B0, 1, 0); PG8_LDB(B1, 1, 1); PG8_SCHED; PG8_LDA(At, 1, 0); PG8_STAGE(PG8_SA(0, 1), a2 + hstep, voffA);
            PG8_WAIT_V(8); PG8_WAIT_L(0); PG8_BAR; PG8_MMA(0, 0, At, B0); PG8_MMA(0, 1, At, B1); PG8_BAR; PG8_SCHED;
            PG8_LDA(At, 1, 1); PG8_STAGE(PG8_SB(1, 0), b3, voffB); PG8_STAGE(PG8_SB(1, 1), b3 + hstep, voffB); PG8_STAGE(PG8_SA(1, 0), a3, voffA);
            PG8_WAIT_V(8); PG8_WAIT_L(0); PG8_BAR; PG8_MMA(1, 0, At, B0); PG8_MMA(1, 1, At, B1); PG8_BAR; PG8_SCHED;
            } else {
            PG8_LDB(B0, 0, 0); PG8_SCHED; PG8_LDA(At, 0, 0); PG8_STAGE(PG8_SA(1, 1), a1 + hstep, voffA);
            PG8_WAIT_L(8); PG8_BAR; PG8_WAIT_L(0); PG8_MMA(0, 0, At, B0); PG8_BAR; PG8_SCHED;
            PG8_LDB(B1, 0, 1); PG8_STAGE(PG8_SB(0, 0), b2, voffB);
            PG8_BAR; PG8_WAIT_L(0); PG8_MMA(0, 1, At, B1); PG8_BAR;
            PG8_LDA(At, 0, 1); PG8_STAGE(PG8_SA(0, 0), a2, voffA);
            PG8_BAR; PG8_WAIT_L(0); PG8_MMA(1, 0, At, B0); PG8_BAR; PG8_SCHED;
            PG8_STAGE(PG8_SB(0, 1), b2 + hstep, voffB);
            PG8_WAIT_V(6); PG8_BAR; PG8_MMA(1, 1, At, B1); PG8_BAR;
            PG8_LDB(B0, 1, 0); PG8_SCHED; PG8_LDA(At, 1, 0); PG8_STAGE(PG8_SA(0, 1), a2 + hstep, voffA);
            PG8_WAIT_L(8); PG8_BAR; PG8_WAIT_L(0); PG8_MMA(0, 0, At, B0); PG8_BAR; PG8_SCHED;
            PG8_LDB(B1, 1, 1); PG8_STAGE(PG8_SB(1, 0), b3, voffB);
            PG8_BAR; PG8_WAIT_L(0); PG8_MMA(0, 1, At, B1); PG8_BAR;
            PG8_LDA(At, 1, 1); PG8_STAGE(PG8_SA(1, 0), a3, voffA);
            PG8_BAR; PG8_WAIT_L(0); PG8_MMA(1, 0, At, B0); PG8_BAR; PG8_SCHED;
            PG8_STAGE(PG8_SB(1, 1), b3 + hstep, voffB);
            PG8_WAIT_V(6); PG8_BAR; PG8_MMA(1, 1, At, B1); PG8_BAR;
            }
        }
        if constexpr (ALIGN_EPI) { if (wr == 0) PG8_BAR; }
        if constexpr (!Epi::AFTER_DRAIN) { E.par = ui & 1; E(acc, cur, wr, wc, fr, fq); S.done(cur); }
        if (!has_next) break;
        E.prefetch(nxt, (ui + 1) & 1, wid, lane, lds);
#pragma unroll
        for (int a = 0; a < 2; ++a)
#pragma unroll
            for (int b = 0; b < 2; ++b)
#pragma unroll
                for (int m = 0; m < 4; ++m)
#pragma unroll
                    for (int n = 0; n < 2; ++n) acc[a][b][m][n] = (f32x4){0.f, 0.f, 0.f, 0.f};
        cur = nxt; cA = nA; cB = nB; ++ui;
        if constexpr (ALIGN_EPI) { if (wr == 1) PG8_BAR; }
    }
    PG8_WAIT_V(0);
    if constexpr (!ALIGN_EPI) { if (wr == 0) PG8_BAR; }
    PG8_BAR;
    if constexpr (Epi::AFTER_DRAIN) { E.fused(acc, cur, wr, wc, fr, fq, lds, wid, lane); S.done(cur); }
#undef PG8_SA
#undef PG8_SB
#undef PG8_STAGE
#undef PG8_LDA
#undef PG8_LDB
#undef PG8_MMA
#undef PG8_WAIT_V
#undef PG8_WAIT_L
#undef PG8_BAR
#undef PG8_SCHED
}
}
#define XB_TMO      128
#define XB_XCNT(j)  (256  + 64 * (j))
#define XB_XSUB(j)  (1280 + 64 * (j))
#define XB_XGEN(j)  (2304 + 64 * (j))
#define XB_TOP      3328
#define XB_TOPGEN   3392
#define XCD_BAR_WORDS 3456
#define XB_SPIN_CAP (1u << 18)

__device__ __forceinline__ unsigned xb_ld(unsigned* p)              { return __hip_atomic_load(p, __ATOMIC_RELAXED, __HIP_MEMORY_SCOPE_AGENT); }
__device__ __forceinline__ unsigned xb_add(unsigned* p, unsigned v) { return __hip_atomic_fetch_add(p, v, __ATOMIC_RELAXED, __HIP_MEMORY_SCOPE_AGENT); }
__device__ __forceinline__ unsigned xb_xcc_id() { return (unsigned)__builtin_amdgcn_s_getreg((3 << 11) | 20) & 0xFu; }
#define XB_SPIN(cond, bar) do { unsigned _sp = 0; while (cond) { __builtin_amdgcn_s_sleep(1); \
    if ((++_sp & 255u) == 0u) { if (xb_ld(&(bar)[XB_TMO])) break; if (_sp > XB_SPIN_CAP) { atomicAdd(&(bar)[XB_TMO], 1u); break; } } } } while (0)

struct XcdBarrier {
    unsigned* bar; unsigned x;
    volatile LAS unsigned* st;
};

__device__ __forceinline__ XcdBarrier xcd_barrier_post(unsigned* bar, volatile LAS unsigned* st) {
    XcdBarrier b; b.bar = bar; b.x = xb_xcc_id(); b.st = st;
    if (threadIdx.x == 0) (void)xb_add(&bar[XB_XCNT(b.x)], 1u);
    return b;
}
__device__ __forceinline__ void xcd_barrier_complete(unsigned* bar, unsigned x, unsigned& nloc, unsigned& nx) {
    const unsigned G = gridDim.x * gridDim.y * gridDim.z;
    unsigned sum, cnt, mine, sp = 0u;
    for (;;) {
        sum = 0u; cnt = 0u; mine = 0u;
#pragma unroll
        for (unsigned j = 0; j < 16; ++j) { const unsigned c = xb_ld(&bar[XB_XCNT(j)]); sum += c; cnt += (c > 0u) ? 1u : 0u; mine = (j == x) ? c : mine; }
        if (sum == G) break;
        __builtin_amdgcn_s_sleep(1);
        if ((++sp & 255u) == 0u) { if (xb_ld(&bar[XB_TMO])) break; if (sp > XB_SPIN_CAP) { atomicAdd(&bar[XB_TMO], 1u); break; } }
    }
    nloc = mine > 0u ? mine : 1u; nx = cnt > 0u ? cnt : 1u;
}

__device__ __forceinline__ void xcd_barrier(const XcdBarrier& b) {
    asm volatile("s_waitcnt vmcnt(0)" ::: "memory");
    __syncthreads();
    if (threadIdx.x == 0) {
        unsigned* bar = b.bar;
        __builtin_amdgcn_s_waitcnt(0);
        unsigned nloc = b.st[0], nx = b.st[1];
        if (nloc == 0u) { xcd_barrier_complete(bar, b.x, nloc, nx); b.st[0] = nloc; b.st[1] = nx; }
        const unsigned old = xb_add(&bar[XB_XSUB(b.x)], 1u);
        const unsigned gen = old / nloc;
        if (old + 1u == (gen + 1u) * nloc) {
            __builtin_amdgcn_fence(__ATOMIC_RELEASE, "agent");
            asm volatile("s_waitcnt vmcnt(0)" ::: "memory");
            const unsigned og = xb_add(&bar[XB_TOP], 1u);
            const unsigned tg = og / nx;
            if (og + 1u == (tg + 1u) * nx) xb_add(&bar[XB_TOPGEN], 1u);
            else XB_SPIN(xb_ld(&bar[XB_TOPGEN]) == tg, bar);
            __builtin_amdgcn_fence(__ATOMIC_ACQUIRE, "agent");
            xb_add(&bar[XB_XGEN(b.x)], 1u);
            asm volatile("s_waitcnt vmcnt(0)" ::: "memory");
        } else {
            XB_SPIN(xb_ld(&bar[XB_XGEN(b.x)]) == gen, bar);
            __builtin_amdgcn_fence(__ATOMIC_ACQUIRE, "agent");
            asm volatile("s_waitcnt vmcnt(0)" ::: "memory");
        }
    }
    __syncthreads();
}
namespace cg = cooperative_groups;
#define LAS __attribute__((address_space(3)))
typedef unsigned short bf16_t;
typedef short bf16x8 __attribute__((ext_vector_type(8)));
typedef short s16x4 __attribute__((ext_vector_type(4)));
typedef float f32x4 __attribute__((ext_vector_type(4)));
typedef float f32x16 __attribute__((ext_vector_type(16)));
typedef unsigned u32x4 __attribute__((ext_vector_type(4)));
typedef unsigned u32x2 __attribute__((ext_vector_type(2)));

constexpr int DM = 2048, MP = 16384, MS = 1024, M = MP + MS;
constexpr int DFF = 5632, NUP = 2 * DFF, NIN = 6400  , NINR = 6160;
constexpr float EPS = 1e-6f;
constexpr int NWAVES = 8;
constexpr int LDS_BYTES = 147456;
constexpr size_t OUT_Y = 0, OUT_GLAP = 35651584, OUT_GLAS = 39845888, OUT_CONVP = 56623104, OUT_CONVS = 56803328,
                 OUT_KP = 57524224, OUT_VP = 58572800, OUT_KS = 59621376, OUT_VS = 60145664;
constexpr size_t MiB = 1u << 20;
constexpr size_t WS_WIN = 0;
constexpr size_t WS_GWO = 50 * MiB;
constexpr size_t WS_WKVQ = 66 * MiB;
constexpr size_t WS_WQ3 = 78 * MiB;
constexpr size_t WS_AWO = 86 * MiB;
constexpr size_t WS_WUP = 102 * MiB;
constexpr size_t WS_WDN = 278 * MiB;
constexpr size_t WS_H = 366 * MiB;
constexpr size_t WS_MF = 434 * MiB;
constexpr size_t WS_KVP = 570 * MiB;
constexpr size_t WS_KVS = 602 * MiB;
constexpr size_t WS_HF = 620 * MiB;
constexpr size_t WS_O = WS_HF, WS_OG = WS_HF + 68 * MiB, WS_Q = WS_HF;
constexpr size_t WS_SCR = 808 * MiB;
constexpr size_t WS_U = WS_SCR, WS_PROJ = WS_SCR, WS_GPRE = WS_SCR + 213 * MiB;
constexpr size_t GPRE_ITEM = 32768 + 8192 + 65536 + 1024 + 32768;
constexpr size_t WS_UST = WS_H;
constexpr size_t WS_END = WS_SCR + 374 * MiB;
static_assert(WS_GPRE + 1088 * GPRE_ITEM <= WS_END, "gpre fits");
static_assert(WS_UST + (size_t)1088 * 262144 <= WS_OG, "ust fits below OG");
constexpr size_t WS_CTL = WS_END, CTL_BYTES = 65536, WS_END2 = WS_END + MiB;
constexpr size_t WS_GT = WS_END2, WS_GH = WS_GT + 13 * MiB, WS_VH = WS_GH + 13 * MiB, WS_END3 = WS_VH + 13 * MiB;
constexpr size_t WS_MFP = WS_END3, WS_END4 = WS_MFP + 64 * MiB;
constexpr size_t WS_XB = WS_END4, WS_END5 = WS_XB + 68 * MiB;
constexpr size_t WS_RS = WS_END5, WS_END6 = WS_RS + MiB;
constexpr int LDS_BARST = 147392;

__device__ __forceinline__ float bf2f(unsigned v) { return __uint_as_float(v << 16); }
__device__ __forceinline__ unsigned f2bf_sw(float f) { unsigned u = __float_as_uint(f); return (u + 0x7fffu + ((u >> 16) & 1u)) >> 16; }
typedef float f32x2_t __attribute__((ext_vector_type(2))); typedef __bf16 bf16x2_t __attribute__((ext_vector_type(2)));
__device__ __forceinline__ unsigned pk2(float lo, float hi) { f32x2_t v = {lo, hi}; bf16x2_t b = __builtin_convertvector(v, bf16x2_t); return __builtin_bit_cast(unsigned, b); }
__device__ __forceinline__ unsigned pk2_sw(float lo, float hi) { return pk2(lo, hi); }
__device__ __forceinline__ unsigned f2bf(float f) { return pk2(f, f) & 0xffffu; }
__device__ __forceinline__ float wave_sum(float v) {
#pragma unroll
    for (int o = 1; o < 64; o <<= 1) v += __shfl_xor(v, o);
    return v;
}
__device__ __forceinline__ float silu_f(float x) { return x * __builtin_amdgcn_rcpf(1.f + __expf(-x)); }

#define LDS_BARRIER() asm volatile("s_waitcnt lgkmcnt(0)\n\ts_barrier" ::: "memory")
struct Args { const float* in[21]; float* out; unsigned char* ws; int ph_lo, ph_hi; };
typedef const Args __attribute__((address_space(4))) CArgs;
__device__ __forceinline__ CArgs* get_args() { CArgs* p = (CArgs*)__builtin_amdgcn_kernarg_segment_ptr(); asm volatile("" : "+s"(p)); return p; }

__device__ __forceinline__ void tr_load(f32x4 (&v)[16], float (&gv)[16], const float* W, int ldw, int ncols, const float* gain, int item, int lane) {
    const int nblk = ncols / 64, kb = item / nblk, nb = item % nblk, k0 = 64 * kb, n0 = 64 * nb, l16 = lane & 15, r2 = lane >> 4;
#pragma unroll
    for (int j = 0; j < 16; ++j) v[j] = __builtin_nontemporal_load((const f32x4*)(W + (size_t)(k0 + 8 * (j >> 1) + 2 * r2 + (j & 1)) * ldw + n0 + 4 * l16));
#pragma unroll
    for (int j = 0; j < 16; ++j) gv[j] = gain ? gain[k0 + 8 * (j >> 1) + 2 * r2 + (j & 1)] : 1.f;
}
__device__ __forceinline__ void tr_store(const f32x4 (&v)[16], const float (&gv)[16], int K, int ncols, int qcols, float qscale, bf16_t* WT, LAS unsigned* scr, int item, int lane, int permup) {
    const int nblk = ncols / 64, kb = item / nblk, nb = item % nblk, k0 = 64 * kb, n0 = 64 * nb;
    const float sc = (n0 < qcols) ? qscale : 1.f;
    const int nd0 = permup ? 256 * ((n0 % 5632) / 128) + 128 * (n0 / 5632) + (n0 % 128) : n0;
    const int l16 = lane & 15, r2 = lane >> 4;
#pragma unroll
    for (int jp = 0; jp < 8; ++jp) {
        const float g0 = gv[2 * jp] * sc, g1 = gv[2 * jp + 1] * sc;
#pragma unroll
        for (int i = 0; i < 4; ++i) scr[(4 * l16 + i) * 33 + 4 * jp + r2] = pk2(v[2 * jp][i] * g0, v[2 * jp + 1][i] * g1);
    }
    asm volatile("s_waitcnt lgkmcnt(0)" ::: "memory");
    const int c = lane & 7;
#pragma unroll
    for (int jj = 0; jj < 8; ++jj) { const int n = (lane >> 3) + 8 * jj; const LAS unsigned* s = scr + n * 33 + 4 * c;
        u32x4 o; o.x = s[0]; o.y = s[1]; o.z = s[2]; o.w = s[3];
        *(u32x4*)(WT + (size_t)(nd0 + n) * K + k0 + 8 * c) = o; }
    asm volatile("s_waitcnt lgkmcnt(0)" ::: "memory");
}

__device__ __forceinline__ void kvs_cache_convert(CArgs* a, int vcu, int G) {
    const int tid = opq_tid(); unsigned char* ws = a->ws;
    const int gt = vcu * 512 + tid, NT = G * 512;
    for (int i = gt; i < 16 * 512 * 128; i += NT) {
        const int bp = i >> 7, c4 = (i & 127) * 4;
        const f32x4 kv = *(const f32x4*)(a->in[4] + (size_t)bp * 512 + c4), vv = *(const f32x4*)(a->in[5] + (size_t)bp * 512 + c4);
        const int b = bp >> 9, p = bp & 511;
        bf16_t* dst = (bf16_t*)(ws + WS_KVS) + ((size_t)b * 576 + p) * 1024 + c4;
        u32x2 w; w.x = pk2(kv[0], kv[1]); w.y = pk2(kv[2], kv[3]); *(u32x2*)dst = w;
        w.x = pk2(vv[0], vv[1]); w.y = pk2(vv[2], vv[3]); *(u32x2*)(dst + 512) = w;
    }
}

#define P0_JOB(idx_, jW, jldw, jK, jncols, jgain, jqcols, jqscale, jWT, jperm, jit) do { int r_ = (idx_), j_ = 0; \
        if (r_ >= 3072) { r_ -= 3072; j_ = 1; if (r_ >= 3072) { r_ -= 3072; j_ = 2; if (r_ >= 1024) { r_ -= 1024; j_ = 3; if (r_ >= 1024) { r_ -= 1024; j_ = 4; if (r_ >= 512) { r_ -= 512; j_ = 5; \
        if (r_ >= 1024) { r_ -= 1024; j_ = 6; if (r_ >= 1024) { r_ -= 1024; j_ = 7; if (r_ >= 1024) { r_ -= 1024; j_ = 8; if (r_ >= 1024) { r_ -= 1024; j_ = 9 + r_ / 5632; r_ = r_ % 5632; \
        if (j_ >= 13) { r_ = (idx_) - 35328; j_ = 13 + r_ / 2816; r_ = r_ % 2816; } } } } } } } } } } \
        jit = r_; jqcols = 0; jgain = nullptr; jqscale = 1.f; jperm = 0; const int j = j_; \
        if (j < 2)       { jW = a->in[7] + (size_t)j * 2048 * NINR; jldw = NINR; jK = 2048; jncols = 6144; jgain = gains + (j * 4 + 0) * 2048; jqcols = 1024; jqscale = 0.0625f; jWT = (bf16_t*)(ws + WS_WIN) + (size_t)j * NIN * 2048; } \
        else if (j < 4)  { const int l = j - 2; jW = a->in[11] + (size_t)l * 2048 * 2048; jldw = 2048; jK = 2048; jncols = 2048; jWT = (bf16_t*)(ws + WS_GWO) + (size_t)l * 2048 * 2048; } \
        else if (j == 4) { jW = a->in[13]; jldw = 1024; jK = 2048; jncols = 1024; jgain = a->in[12]; jWT = (bf16_t*)(ws + WS_WKVQ); } \
        else if (j == 5) { jW = a->in[14]; jldw = 2048; jK = 2048; jncols = 2048; jgain = gains + (2 * 4 + 0) * 2048; jqcols = 2048; jqscale = 0.12751743074602625f  ; jWT = (bf16_t*)(ws + WS_WKVQ) + (size_t)1024 * 2048; } \
        else if (j == 6) { jW = a->in[14] + (size_t)2048 * 2048; jldw = 2048; jK = 2048; jncols = 2048; jgain = gains + (3 * 4 + 0) * 2048; jqcols = 2048; jqscale = 0.12751743074602625f; jWT = (bf16_t*)(ws + WS_WQ3); } \
        else if (j < 9)  { const int l = j - 7; jW = a->in[16] + (size_t)l * 2048 * 2048; jldw = 2048; jK = 2048; jncols = 2048; jWT = (bf16_t*)(ws + WS_AWO) + (size_t)l * 2048 * 2048; } \
        else if (j < 13) { const int l = j - 9; jW = a->in[17] + (size_t)l * 2048 * NUP; jldw = NUP; jK = 2048; jncols = NUP; jgain = gains + (l * 4 + 2) * 2048; jWT = (bf16_t*)(ws + WS_WUP) + (size_t)l * NUP * 2048; jperm = 1; } \
        else             { const int l = j - 13; jW = a->in[20] + (size_t)l * DFF * 2048; jldw = 2048; jK = DFF; jncols = 2048; jWT = (bf16_t*)(ws + WS_WDN) + (size_t)l * 2048 * DFF; } } while (0)
__device__ __forceinline__ int layer_tile(int L, int v) {
    if (L < 2) { if (v < 3072) return L * 3072 + v; v -= 3072; if (v < 1024) return 6144 + L * 1024 + v; v -= 1024; if (v < 5632) return 12800 + L * 5632 + v; v -= 5632; return 35328 + L * 2816 + v; }
    if (L == 2) { if (v < 512) return 8192 + v; v -= 512; if (v < 1024) return 8704 + v; v -= 1024; if (v < 1024) return 10752 + v; v -= 1024; if (v < 5632) return 12800 + 2 * 5632 + v; v -= 5632; return 35328 + 2 * 2816 + v; }
    if (v < 1024) return 9728 + v; v -= 1024; if (v < 1024) return 11776 + v; v -= 1024; if (v < 5632) return 12800 + 3 * 5632 + v; v -= 5632; return 35328 + 3 * 2816 + v;
}
__device__ __forceinline__ void convert_layer_tiles(CArgs* a, LAS unsigned char* lds, int L, int v0, int v1, int widx, int nw) {
    const int tid = opq_tid(), lane = tid & 63, wave = __builtin_amdgcn_readfirstlane(tid >> 6);
    LAS unsigned* scr = (LAS unsigned*)(lds + wave * 16384);
    unsigned char* ws = a->ws; const float* gains = a->in[6];
    f32x4 v[16], vn[16]; float gv[16], gn[16];
    const float* cW; int cldw, cK, cncols, cqcols, cperm, cit; const float* cgain; float cqscale; bf16_t* cWT;
    int vi = v0 + widx;
    if (vi < v1) { P0_JOB(layer_tile(L, vi), cW, cldw, cK, cncols, cgain, cqcols, cqscale, cWT, cperm, cit); tr_load(v, gv, cW, cldw, cncols, cgain, cit, lane); }
    while (vi < v1) {
        const int nx = vi + nw;
        const float* nW = cW; int nldw = cldw, nK = cK, nncols = cncols, nqcols = cqcols, nperm = cperm, nit = cit; const float* ngain = cgain; float nqscale = cqscale; bf16_t* nWT = cWT;
        if (nx < v1) { P0_JOB(layer_tile(L, nx), nW, nldw, nK, nncols, ngain, nqcols, nqscale, nWT, nperm, nit); tr_load(vn, gn, nW, nldw, nncols, ngain, nit, lane); }
        tr_store(v, gv, cK, cncols, cqcols, cqscale, cWT, scr, cit, lane, cperm);
#pragma unroll
        for (int q = 0; q < 16; ++q) { v[q] = vn[q]; gv[q] = gn[q]; }
        cW = nW; cldw = nldw; cK = nK; cncols = nncols; cgain = ngain; cqcols = nqcols; cqscale = nqscale; cWT = nWT; cperm = nperm; cit = nit;
        vi = nx;
    }
}
__device__ __forceinline__ void convert_in_phase(CArgs* a, LAS unsigned char* lds, int G, int bx, int l, int rem, int pf0, int pf1) {
    if (G != 256 || l >= 3 || bx < rem) return;
    const int NT = (l + 1 < 2) ? 12544 : (l + 1 == 2 ? 11008 : 10496);
    const int p0 = (int)((long)NT * pf0 / 1024), p1 = (int)((long)NT * pf1 / 1024), nI = 256 - rem, cnt = (p1 - p0 + nI - 1) / nI;
    const int v0 = p0 + (bx - rem) * cnt, v1 = (v0 + cnt < p1) ? v0 + cnt : p1;
    const int wave = __builtin_amdgcn_readfirstlane((int)(threadIdx.x >> 6));
    __syncthreads();
    convert_layer_tiles(a, lds, l + 1, v0, v1, wave, 8);
}
__device__ __forceinline__ void p0_prologue(CArgs* a, LAS unsigned char* lds, int vcu, int G) {
    const int tid = opq_tid(), lane = tid & 63, wave = __builtin_amdgcn_readfirstlane(tid >> 6);
    LAS unsigned* scr = (LAS unsigned*)(lds + wave * 16384);
    const int gw = vcu * NWAVES + wave, NGW = G * NWAVES;
    unsigned char* ws = a->ws;
    const float* gains = a->in[6];
    if (G == 256) convert_layer_tiles(a, lds, 0, 0, 12544, gw, NGW);
    else { convert_layer_tiles(a, lds, 0, 0, 12544, gw, NGW); convert_layer_tiles(a, lds, 1, 0, 12544, gw, NGW); convert_layer_tiles(a, lds, 2, 0, 11008, gw, NGW); convert_layer_tiles(a, lds, 3, 0, 10496, gw, NGW); }
    const int gt = vcu * 512 + tid, NT = G * 512;
    for (int i = gt; i < 2 * 2048 * 256; i += NT) {
        const int l = i / (2048 * 256), r = i % (2048 * 256), n = r / 2048, k = r % 2048;
        float v = 0.f;
        if (n < 16) v = a->in[7][((size_t)l * 2048 + k) * NINR + 6144 + n] * gains[(l * 4 + 0) * 2048 + k];
        ((bf16_t*)(ws + WS_WIN))[((size_t)l * NIN + 6144 + n) * 2048 + k] = (bf16_t)f2bf(v);
    }
    {
        f32x4 v[8], vn[8];
        int row = gw;
        if (row < M) { const float* xr = row < MP ? a->in[0] + (size_t)row * DM : a->in[1] + (size_t)(row - MP) * DM;
#pragma unroll
            for (int j = 0; j < 8; ++j) v[j] = __builtin_nontemporal_load((const f32x4*)(xr + 4 * lane + 256 * j)); }
        for (; row < M; row += NGW) {
            const int nr = row + NGW;
            if (nr < M) { const float* xr = nr < MP ? a->in[0] + (size_t)nr * DM : a->in[1] + (size_t)(nr - MP) * DM;
#pragma unroll
                for (int j = 0; j < 8; ++j) vn[j] = __builtin_nontemporal_load((const f32x4*)(xr + 4 * lane + 256 * j)); }
            float s = 0.f;
#pragma unroll
            for (int j = 0; j < 8; ++j) s += (v[j][0] * v[j][0] + v[j][1] * v[j][1]) + (v[j][2] * v[j][2] + v[j][3] * v[j][3]);
            const float r = rsqrtf(wave_sum(s) * (1.f / DM) + EPS);
            bf16_t* hr = (bf16_t*)(ws + WS_XB) + (size_t)row * DM;
#pragma unroll
            for (int j = 0; j < 8; ++j) { u32x2 w; w.x = pk2(v[j][0], v[j][1]); w.y = pk2(v[j][2], v[j][3]); *(u32x2*)(hr + 4 * lane + 256 * j) = w; }
            if (lane == 0) ((float*)(ws + WS_RS))[row] = r;
#pragma unroll
            for (int j = 0; j < 8; ++j) v[j] = vn[j];
        }
    }
}

template <bool LAST> __device__ __forceinline__ void norm_row(f32x4 (&xv)[8], const f32x4 (&mv)[8], const f32x4 (&g)[8], float* xo32, bf16_t* xo16, bf16_t* hr, int lane) {
    constexpr bool want_h = !LAST;
    float s = 0.f;
#pragma unroll
    for (int j = 0; j < 8; ++j) s += (mv[j][0] * mv[j][0] + mv[j][1] * mv[j][1]) + (mv[j][2] * mv[j][2] + mv[j][3] * mv[j][3]);
    const float r1 = rsqrtf(wave_sum(s) * (1.f / DM) + EPS);
    float s2 = 0.f;
#pragma unroll
    for (int j = 0; j < 8; ++j) { xv[j] = xv[j] + mv[j] * r1 * g[j];
        s2 += (xv[j][0] * xv[j][0] + xv[j][1] * xv[j][1]) + (xv[j][2] * xv[j][2] + xv[j][3] * xv[j][3]);
        if (LAST) *(f32x4*)(xo32 + 4 * lane + 256 * j) = xv[j];
        else { u32x2 w; w.x = pk2(xv[j][0], xv[j][1]); w.y = pk2(xv[j][2], xv[j][3]); *(u32x2*)(xo16 + 4 * lane + 256 * j) = w; } }
    if (want_h) {
        const float r2 = rsqrtf(wave_sum(s2) * (1.f / DM) + EPS);
        if (lane == 0) *(float*)hr = r2;
    }
}
__device__ __forceinline__ f32x4 unpk4(u32x2 p) { return (f32x4){bf2f(p.x & 0xffffu), bf2f(p.x >> 16), bf2f(p.y & 0xffffu), bf2f(p.y >> 16)}; }
__device__ __forceinline__ void norm_pass(CArgs* a, LAS unsigned char* lds, int vcu, int G, const float* gpost, bool first, bool want_h, int nsplit) {
    const int tid = opq_tid(), lane = tid & 63, wave = tid >> 6;
    const int gw = vcu * NWAVES + wave, NGW = G * NWAVES;
    float* Y = a->out + OUT_Y; bf16_t* XB = (bf16_t*)(a->ws + WS_XB); const bf16_t* MF = (const bf16_t*)(a->ws + WS_MF); float* RS = (float*)(a->ws + WS_RS);
    const bool last = !want_h;
    f32x4 g[8];
#pragma unroll
    for (int j = 0; j < 8; ++j) g[j] = *(const f32x4*)(gpost + 4 * lane + 256 * j);
    if (first) {
        for (int row = gw; row < MP; row += NGW) {
            f32x4 xv[8], mv[8];
#pragma unroll
            for (int j = 0; j < 8; ++j) { xv[j] = *(const f32x4*)(a->in[0] + (size_t)row * DM + 4 * lane + 256 * j); mv[j] = unpk4(*(const u32x2*)(MF + (size_t)row * DM + 4 * lane + 256 * j)); }
            norm_row<false>(xv, mv, g, nullptr, XB + (size_t)row * DM, (bf16_t*)(RS + row), lane);
        }
    } else {
        u32x2 xa[8], xb[8], xc[8], ma[8], mb[8], mc[8];
        int row = gw;
#define NP_LOAD(xd, md, r_) do { _Pragma("unroll") for (int j = 0; j < 8; ++j) { xd[j] = *(const u32x2*)(XB + (size_t)(r_) * DM + 4 * lane + 256 * j); md[j] = *(const u32x2*)(MF + (size_t)(r_) * DM + 4 * lane + 256 * j); } } while (0)
        if (row < MP) NP_LOAD(xa, ma, row);
        if (row + NGW < MP) NP_LOAD(xb, mb, row + NGW);
        for (; row < MP; row += NGW) {
            const int nr = row + 2 * NGW;
            if (nr < MP) NP_LOAD(xc, mc, nr);
            f32x4 xv[8], mv[8];
#pragma unroll
            for (int j = 0; j < 8; ++j) { xv[j] = unpk4(xa[j]); mv[j] = unpk4(ma[j]); }
            if (last) norm_row<true>(xv, mv, g, Y + (size_t)row * DM, nullptr, nullptr, lane); else norm_row<false>(xv, mv, g, nullptr, XB + (size_t)row * DM, (bf16_t*)(RS + row), lane);
#pragma unroll
            for (int j = 0; j < 8; ++j) { xa[j] = xb[j]; ma[j] = mb[j]; xb[j] = xc[j]; mb[j] = mc[j]; }
        }
#undef NP_LOAD
    }
    if (G == 256) {
        LAS float* red = (LAS float*)lds;
        const int rl = wave & 3, hf = wave >> 2, row = MP + 4 * vcu + rl, c0 = 1024 * hf + 4 * lane;
        f32x4 xv[4], mv[4];
#pragma unroll
        for (int j = 0; j < 4; ++j) { xv[j] = unpk4(*(const u32x2*)(XB + (size_t)row * DM + c0 + 256 * j)); mv[j] = (f32x4){0.f, 0.f, 0.f, 0.f}; }
        const float* pp = (const float*)(a->ws + WS_MFP) + (size_t)(row - MP) * DM + c0;
        if (nsplit == 8) { f32x4 p[8][4];
#pragma unroll
            for (int sp = 0; sp < 8; ++sp)
#pragma unroll
                for (int j = 0; j < 4; ++j) p[sp][j] = *(const f32x4*)(pp + (size_t)sp * MS * DM + 256 * j);
#pragma unroll
            for (int j = 0; j < 4; ++j) mv[j] = ((p[0][j] + p[1][j]) + (p[2][j] + p[3][j])) + ((p[4][j] + p[5][j]) + (p[6][j] + p[7][j])); }
        else { f32x4 p[4][4];
#pragma unroll
            for (int sp = 0; sp < 4; ++sp)
#pragma unroll
                for (int j = 0; j < 4; ++j) p[sp][j] = *(const f32x4*)(pp + (size_t)sp * MS * DM + 256 * j);
#pragma unroll
            for (int j = 0; j < 4; ++j) mv[j] = (p[0][j] + p[1][j]) + (p[2][j] + p[3][j]); }
        float s = 0.f;
#pragma unroll
        for (int j = 0; j < 4; ++j) s += (mv[j][0] * mv[j][0] + mv[j][1] * mv[j][1]) + (mv[j][2] * mv[j][2] + mv[j][3] * mv[j][3]);
        s = wave_sum(s);
        __syncthreads();
        if (lane == 0) red[rl * 2 + hf] = s;
        __syncthreads();
        const float r1 = rsqrtf((red[rl * 2] + red[rl * 2 + 1]) * (1.f / DM) + EPS);
        float s2 = 0.f;
#pragma unroll
        for (int j = 0; j < 4; ++j) { const f32x4 gg = *(const f32x4*)(gpost + c0 + 256 * j); xv[j] = xv[j] + mv[j] * r1 * gg;
            s2 += (xv[j][0] * xv[j][0] + xv[j][1] * xv[j][1]) + (xv[j][2] * xv[j][2] + xv[j][3] * xv[j][3]);
            if (last) *(f32x4*)(Y + (size_t)row * DM + c0 + 256 * j) = xv[j];
            else { u32x2 w; w.x = pk2(xv[j][0], xv[j][1]); w.y = pk2(xv[j][2], xv[j][3]); *(u32x2*)(XB + (size_t)row * DM + c0 + 256 * j) = w; } }
        if (!last) {
            s2 = wave_sum(s2);
            if (lane == 0) red[8 + rl * 2 + hf] = s2;
            __syncthreads();
            if (hf == 0 && lane == 0) RS[row] = rsqrtf((red[8 + rl * 2] + red[8 + rl * 2 + 1]) * (1.f / DM) + EPS);
        }
    } else {
#pragma unroll 1
    for (int row = MP + gw; row < M; row += NGW) {
        f32x4 xv[8], mv[8];
#pragma unroll
        for (int j = 0; j < 8; ++j) { xv[j] = unpk4(*(const u32x2*)(XB + (size_t)row * DM + 4 * lane + 256 * j)); mv[j] = (f32x4){0.f, 0.f, 0.f, 0.f}; }
#pragma unroll 1
        for (int sp = 0; sp < nsplit; sp += 2) {
            const float* pp = (const float*)(a->ws + WS_MFP) + (size_t)sp * MS * DM + (size_t)(row - MP) * DM + 4 * lane;
            f32x4 p0[8], p1[8];
#pragma unroll
            for (int j = 0; j < 8; ++j) { p0[j] = *(const f32x4*)(pp + 256 * j); p1[j] = *(const f32x4*)(pp + (size_t)MS * DM + 256 * j); }
#pragma unroll
            for (int j = 0; j < 8; ++j) mv[j] = mv[j] + (p0[j] + p1[j]);
        }
        if (last) norm_row<true>(xv, mv, g, Y + (size_t)row * DM, nullptr, nullptr, lane); else norm_row<false>(xv, mv, g, nullptr, XB + (size_t)row * DM, (bf16_t*)(RS + row), lane);
    }
    }
}

__device__ __forceinline__ void conv_pass(CArgs* a, int vcu, int G, int l) {
    const int tid = opq_tid();
    const int gt = vcu * 512 + tid, NT = G * 512;
    bf16_t* HF = (bf16_t*)(a->ws + WS_HF);
    const float* GT = (const float*)(a->ws + WS_GT); const float* GH = (const float*)(a->ws + WS_GH); const float* VH = (const float*)(a->ws + WS_VH);
    const float* cw = a->in[18] + (size_t)l * 3 * DFF; const float* cb = a->in[19] + (size_t)l * DFF;
    for (int i = gt; i < 272 * 1408; i += NT) {
        const int rb = i / 1408, j0 = (i % 1408) * 4;
        const f32x4 w0 = *(const f32x4*)(cw + j0), w1 = *(const f32x4*)(cw + DFF + j0), w2 = *(const f32x4*)(cw + 2 * DFF + j0), bb = *(const f32x4*)(cb + j0);
        f32x4 gm2 = (f32x4){0.f, 0.f, 0.f, 0.f}, gm1 = gm2;
        if (rb >= 256) { const float* st = a->in[3] + ((size_t)(l * 16 + (rb - 256)) * 2) * DFF + j0; gm2 = *(const f32x4*)st; gm1 = *(const f32x4*)(st + DFF); }
        else if ((rb & 63) != 0) { gm2 = *(const f32x4*)(GT + ((size_t)(rb - 1) * 2) * DFF + j0); gm1 = *(const f32x4*)(GT + ((size_t)(rb - 1) * 2 + 1) * DFF + j0); }
        const f32x4 g0 = *(const f32x4*)(GH + ((size_t)rb * 2) * DFF + j0), g1 = *(const f32x4*)(GH + ((size_t)rb * 2 + 1) * DFF + j0);
        const f32x4 v0 = *(const f32x4*)(VH + ((size_t)rb * 2) * DFF + j0), v1 = *(const f32x4*)(VH + ((size_t)rb * 2 + 1) * DFF + j0);
        const f32x4 c0 = bb + w0 * gm2 + w1 * gm1 + w2 * g0, c1 = bb + w0 * gm1 + w1 * g0 + w2 * g1;
        u32x2 o0, o1;
        o0.x = pk2(silu_f(c0[0]) * v0[0], silu_f(c0[1]) * v0[1]); o0.y = pk2(silu_f(c0[2]) * v0[2], silu_f(c0[3]) * v0[3]);
        o1.x = pk2(silu_f(c1[0]) * v1[0], silu_f(c1[1]) * v1[1]); o1.y = pk2(silu_f(c1[2]) * v1[2], silu_f(c1[3]) * v1[3]);
        *(u32x2*)(HF + (size_t)(rb * 64) * DFF + j0) = o0; *(u32x2*)(HF + (size_t)(rb * 64 + 1) * DFF + j0) = o1;
        float* cout = nullptr;
        if (rb >= 256) cout = a->out + OUT_CONVS + ((size_t)(l * 16 + (rb - 256)) * 2) * DFF + j0;
        else if ((rb & 63) == 63) cout = a->out + OUT_CONVP + ((size_t)(l * 4 + (rb >> 6)) * 2) * DFF + j0;
        if (cout) { *(f32x4*)cout = *(const f32x4*)(GT + ((size_t)rb * 2) * DFF + j0); *(f32x4*)(cout + DFF) = *(const f32x4*)(GT + ((size_t)rb * 2 + 1) * DFF + j0); }
    }
}

constexpr size_t GP_QI = 0, GP_P = 32768, GP_VT = 40960, GP_DEC = 106496, GP_KET = 107520;
__device__ __forceinline__ void gla_pre(CArgs* a, LAS unsigned char* lds, int vcu, int G, int l) {
    const int tid = opq_tid(), lane = tid & 63, wave = __builtin_amdgcn_readfirstlane(tid >> 6);
    LAS float* glow = (LAS float*)lds;
    LAS float* tot = (LAS float*)(lds + 4096);
    LAS float* BcL = (LAS float*)(lds + 8192);
    LAS bf16_t* QaL = (LAS bf16_t*)(lds + 73728);
    LAS bf16_t* KeL = (LAS bf16_t*)(lds + 107520);
    LAS bf16_t* KeTL = (LAS bf16_t*)(lds + 8192);
    LAS unsigned* VTLw = (LAS unsigned*)(lds + 45056);
    LAS bf16_t* VTL = (LAS bf16_t*)(lds + 45056);
    const bf16_t* PROJ = (const bf16_t*)(a->ws + WS_PROJ);
    const float* wgate = a->in[8] + (size_t)l * 16 * 1024; const float* bgate = a->in[9] + (size_t)l * 1024;
    for (int it = vcu; it < 1088; it += G) {
        int row0, h;
        if (it < 1024) { const int s = it >> 6, c = it & 63; h = s & 3; row0 = (s >> 2) * 4096 + c * 64; }
        else { const int s = it - 1024; h = s & 3; row0 = MP + (s >> 2) * 64; }
        const bf16_t* P = PROJ + (size_t)row0 * NIN;
        unsigned char* gp = a->ws + WS_GPRE + (size_t)it * GPRE_ITEM;
        bf16_t* Qi = (bf16_t*)(gp + GP_QI); bf16_t* Pg = (bf16_t*)(gp + GP_P); bf16_t* VT = (bf16_t*)(gp + GP_VT); float* dec = (float*)(gp + GP_DEC);
        LDS_BARRIER();
        for (int i = tid; i < 1024; i += 512) glow[i] = bf2f(P[(size_t)(i >> 4) * NIN + 6144 + (i & 15)]);
        u32x4 qpre[4], kpre[4];
#pragma unroll
        for (int jj = 0; jj < 4; ++jj) { qpre[jj] = *(const u32x4*)(P + (size_t)(tid >> 3) * NIN + h * 256 + (tid & 7) * 32 + 8 * jj); kpre[jj] = *(const u32x4*)(P + (size_t)(tid >> 3) * NIN + 1024 + h * 256 + (tid & 7) * 32 + 8 * jj); }
        LDS_BARRIER();
        {
            const int c = tid & 255, half = tid >> 8, col = h * 256 + c;
            float wg[16];
#pragma unroll
            for (int r = 0; r < 16; ++r) wg[r] = wgate[r * 1024 + col];
            const float bgv = bgate[col];
            float run = 0.f;
#pragma unroll 2
            for (int i = 0; i < 32; ++i) {
                const int t = half * 32 + i; float z = bgv;
#pragma unroll
                for (int r4 = 0; r4 < 4; ++r4) { const f32x4 gl = *(const LAS f32x4*)(glow + t * 16 + 4 * r4); z += gl[0] * wg[4 * r4] + gl[1] * wg[4 * r4 + 1] + gl[2] * wg[4 * r4 + 2] + gl[3] * wg[4 * r4 + 3]; }
                const float gk = -(fmaxf(-z, 0.f) + __logf(1.f + __expf(-fabsf(z)))) * 0.0625f;
                run += gk; BcL[t * 256 + c] = run;
            }
            tot[half * 256 + c] = run;
        }
        LDS_BARRIER();
        {
            const int t = tid >> 3, c0 = (tid & 7) * 32;
#pragma unroll
            for (int jj = 0; jj < 4; ++jj) {
                const int c = c0 + 8 * jj;
                const u32x4 qv = qpre[jj], kv = kpre[jj];
                float bt[8], be[8];
                { const f32x4 b0 = *(const LAS f32x4*)(BcL + t * 256 + c), b1 = *(const LAS f32x4*)(BcL + t * 256 + c + 4);
                  const f32x4 t00 = *(const LAS f32x4*)(tot + c), t01 = *(const LAS f32x4*)(tot + c + 4), t10 = *(const LAS f32x4*)(tot + 256 + c), t11 = *(const LAS f32x4*)(tot + 256 + c + 4);
#pragma unroll
                  for (int e = 0; e < 4; ++e) { bt[e] = b0[e] + (t >= 32 ? t00[e] : 0.f); bt[4 + e] = b1[e] + (t >= 32 ? t01[e] : 0.f); be[e] = t00[e] + t10[e]; be[4 + e] = t01[e] + t11[e]; } }
                u32x4 oqi, oqa, oke;
#pragma unroll
                for (int e = 0; e < 4; ++e) {
                    const float q0 = bf2f(qv[e] & 0xffffu), q1 = bf2f(qv[e] >> 16), k0 = bf2f(kv[e] & 0xffffu), k1 = bf2f(kv[e] >> 16);
                    const float e0 = __expf(bt[2 * e]), e1 = __expf(bt[2 * e + 1]), d0 = __expf(bt[2 * e] - be[2 * e]), d1 = __expf(bt[2 * e + 1] - be[2 * e + 1]);
                    oqi[e] = pk2(q0 * e0, q1 * e1); oqa[e] = pk2(q0 * d0, q1 * d1); oke[e] = pk2(k0 / d0, k1 / d1);
                }
                *(u32x4*)(Qi + t * 256 + c) = oqi;
                *(LAS u32x4*)(QaL + t * 264 + c) = oqa; *(LAS u32x4*)(KeL + t * 264 + c) = oke;
            }
            if (tid < 256) dec[tid] = __expf(tot[tid] + tot[256 + tid]);
        }
        u32x4 vr0[4], vr1[4];
#pragma unroll
        for (int itr = 0; itr < 4; ++itr) { const int sp = itr * 8 + (lane >> 3), vc = wave * 8 + (lane & 7);
            vr0[itr] = *(const u32x4*)(P + (size_t)(2 * sp) * NIN + 2048 + h * 512 + vc * 8); vr1[itr] = *(const u32x4*)(P + (size_t)(2 * sp + 1) * NIN + 2048 + h * 512 + vc * 8); }
        LDS_BARRIER();
        {
            const int mt = wave >> 1, ns0 = 2 * (wave & 1), lr = lane & 15, g = lane >> 4;
            f32x4 pacc[2] = {(f32x4){0.f, 0.f, 0.f, 0.f}, (f32x4){0.f, 0.f, 0.f, 0.f}};
#pragma unroll
            for (int st = 0; st < 8; ++st) {
                const bf16x8 av = *(const LAS bf16x8*)(QaL + (mt * 16 + lr) * 264 + 32 * st + 8 * g);
#pragma unroll
                for (int j = 0; j < 2; ++j) { const bf16x8 bv = *(const LAS bf16x8*)(KeL + ((ns0 + j) * 16 + lr) * 264 + 32 * st + 8 * g);
                    pacc[j] = __builtin_amdgcn_mfma_f32_16x16x32_bf16(av, bv, pacc[j], 0, 0, 0); }
            }
#pragma unroll
            for (int j = 0; j < 2; ++j)
#pragma unroll
                for (int i = 0; i < 4; ++i) { const int t = mt * 16 + 4 * g + i, s = (ns0 + j) * 16 + lr; Pg[t * 64 + s] = (bf16_t)f2bf(s <= t ? pacc[j][i] : 0.f); }
        }
        LDS_BARRIER();
        {
            const int c = tid & 255, half = tid >> 8;
#pragma unroll 1
            for (int j = 0; j < 4; ++j) {
                unsigned w[4];
#pragma unroll
                for (int e = 0; e < 4; ++e) w[e] = (unsigned)KeL[(half * 32 + 8 * j + 2 * e) * 264 + c] | ((unsigned)KeL[(half * 32 + 8 * j + 2 * e + 1) * 264 + c] << 16);
                *(LAS u32x4*)(KeTL + c * 72 + half * 32 + j * 8) = (u32x4){w[0], w[1], w[2], w[3]};
            }
        }
        LDS_BARRIER();
        {
            const int vc = wave * 8 + (lane & 7), sp0 = lane >> 3;
#pragma unroll
            for (int itr = 0; itr < 4; ++itr) {
                const int sp = itr * 8 + sp0;
                const u32x4 r0 = vr0[itr], r1 = vr1[itr];
#pragma unroll
                for (int e = 0; e < 4; ++e) { VTLw[(vc * 8 + 2 * e) * 36 + sp] = (r0[e] & 0xffffu) | (r1[e] << 16); VTLw[(vc * 8 + 2 * e + 1) * 36 + sp] = (r0[e] >> 16) | (r1[e] & 0xffff0000u); }
            }
        }
        LDS_BARRIER();
        {
#pragma unroll
            for (int jj = 0; jj < 8; ++jj) { const int p = tid + 512 * jj, v = p >> 3, cc = p & 7; *(u32x4*)(VT + v * 64 + cc * 8) = *(const LAS u32x4*)(VTL + v * 72 + cc * 8); }
            bf16_t* KeTg = (bf16_t*)(gp + GP_KET);
#pragma unroll
            for (int jj = 0; jj < 4; ++jj) { const int p = tid + 512 * jj; *(u32x4*)(KeTg + (size_t)p * 8) = *(const LAS u32x4*)(KeTL + (p >> 3) * 72 + (p & 7) * 8); }
        }
    }
}

__device__ __forceinline__ void gla_x2_chain(CArgs* a, LAS unsigned char* lds, int item0, int nsteps, int vs, const float* sinit, float* sout) {
    const int tid = opq_tid(), lane = tid & 63, wave = __builtin_amdgcn_readfirstlane(tid >> 6), lr = lane & 15, g = lane >> 4;
    constexpr int BUF = 42496;
    f32x4 S[2][2];
#pragma unroll
    for (int kl = 0; kl < 2; ++kl)
#pragma unroll
        for (int vt = 0; vt < 2; ++vt)
#pragma unroll
            for (int i = 0; i < 4; ++i) S[kl][vt][i] = sinit ? sinit[(size_t)(16 * (2 * wave + kl) + 4 * g + i) * 512 + 32 * vs + 16 * vt + lr] : 0.f;
    u32x4 kregA[4], xregA, kregB[4], xregB;
#define X2_LOAD(KR, XR, c_) do { const unsigned char* gp_ = a->ws + WS_GPRE + (size_t)(item0 + (c_)) * GPRE_ITEM; \
        _Pragma("unroll") for (int j = 0; j < 4; ++j) KR[j] = *(const u32x4*)(gp_ + GP_KET + (size_t)(tid + 512 * j) * 16); \
        if (tid < 256) XR = *(const u32x4*)(gp_ + GP_VT + (size_t)(32 * vs) * 128 + (size_t)tid * 16); \
        else if (tid < 320) XR = *(const u32x4*)(gp_ + GP_DEC + (size_t)(tid - 256) * 16); } while (0)
#define X2_STAGE(KR, XR, b_) do { LAS unsigned char* bb_ = lds + (b_) * BUF; \
        _Pragma("unroll") for (int j = 0; j < 4; ++j) { const int p = tid + 512 * j; *(LAS u32x4*)(bb_ + ((p >> 3) * 72 + (p & 7) * 8) * 2) = KR[j]; } \
        if (tid < 256) *(LAS u32x4*)(bb_ + 36864 + ((tid >> 3) * 72 + (tid & 7) * 8) * 2) = XR; \
        else if (tid < 320) *(LAS u32x4*)(bb_ + 41472 + (tid - 256) * 16) = XR; } while (0)
#define X2_COMPUTE(c_) do { \
            LAS unsigned char* bb = lds + ((c_) % 3) * BUF; \
            const LAS bf16_t* KeTL = (const LAS bf16_t*)bb; const LAS bf16_t* VTL = (const LAS bf16_t*)(bb + 36864); const LAS float* decL = (const LAS float*)(bb + 41472); \
            bf16_t* stp = (bf16_t*)(a->ws + WS_UST) + (size_t)(item0 + (c_)) * 131072 + (size_t)(32 * vs + lr) * 256 + 4 * g; \
            bf16x8 vb[2][2]; \
            _Pragma("unroll") for (int vt = 0; vt < 2; ++vt) _Pragma("unroll") for (int st = 0; st < 2; ++st) vb[vt][st] = *(const LAS bf16x8*)(VTL + (16 * vt + lr) * 72 + 32 * st + 8 * g); \
            _Pragma("unroll") for (int kl = 0; kl < 2; ++kl) { const int kt = 2 * wave + kl; \
                const f32x4 d = *(const LAS f32x4*)(decL + 16 * kt + 4 * g); \
                const bf16x8 a0 = *(const LAS bf16x8*)(KeTL + (kt * 16 + lr) * 72 + 8 * g), a1 = *(const LAS bf16x8*)(KeTL + (kt * 16 + lr) * 72 + 32 + 8 * g); \
                _Pragma("unroll") for (int vt = 0; vt < 2; ++vt) { \
                    u32x2 w; w.x = pk2(S[kl][vt][0], S[kl][vt][1]); w.y = pk2(S[kl][vt][2], S[kl][vt][3]); *(u32x2*)(stp + (size_t)vt * 16 * 256 + 16 * kt) = w; \
                    S[kl][vt] = S[kl][vt] * d; \
                    S[kl][vt] = __builtin_amdgcn_mfma_f32_16x16x32_bf16(a0, vb[vt][0], S[kl][vt], 0, 0, 0); \
                    S[kl][vt] = __builtin_amdgcn_mfma_f32_16x16x32_bf16(a1, vb[vt][1], S[kl][vt], 0, 0, 0); } } } while (0)
    __syncthreads();
    X2_LOAD(kregA, xregA, 0);
    if (nsteps > 1) X2_LOAD(kregB, xregB, 1);
    X2_STAGE(kregA, xregA, 0);
    __syncthreads();
    for (int c = 0; c < nsteps; c += 2) {
        if (c + 2 < nsteps) X2_LOAD(kregA, xregA, c + 2);
        X2_COMPUTE(c);
        if (c + 1 < nsteps) X2_STAGE(kregB, xregB, (c + 1) % 3);
        LDS_BARRIER();
        if (c + 1 >= nsteps) break;
        if (c + 3 < nsteps) X2_LOAD(kregB, xregB, c + 3);
        X2_COMPUTE(c + 1);
        if (c + 2 < nsteps) X2_STAGE(kregA, xregA, (c + 2) % 3);
        LDS_BARRIER();
    }
#undef X2_LOAD
#undef X2_STAGE
#undef X2_COMPUTE
#pragma unroll
    for (int kl = 0; kl < 2; ++kl)
#pragma unroll
        for (int vt = 0; vt < 2; ++vt)
#pragma unroll
            for (int i = 0; i < 4; ++i) sout[(size_t)(16 * (2 * wave + kl) + 4 * g + i) * 512 + 32 * vs + 16 * vt + lr] = S[kl][vt][i];
}
__device__ __forceinline__ void gla_x2(CArgs* a, LAS unsigned char* lds, int vcu, int G, int l) {
    for (int jb = vcu; jb < 256 + 1024; jb += G) {
        const bool pr = jb < 256; const int si = pr ? jb : jb - 256, s = si >> 4, vs = si & 15, b = s >> 2, h = s & 3;
        const float* sinit = pr ? nullptr : a->in[2] + ((size_t)(l * 16 + b) * 4 + h) * 131072;
        float* sout = pr ? a->out + OUT_GLAP + ((size_t)(l * 4 + b) * 4 + h) * 131072 : a->out + OUT_GLAS + ((size_t)(l * 16 + b) * 4 + h) * 131072;
        gla_x2_chain(a, lds, pr ? s * 64 : 1024 + s, pr ? 64 : 1, vs, sinit, sout);
    }
}

__device__ __forceinline__ void gla_x3(CArgs* a, LAS unsigned char* lds, int vcu, int G, int l) {
    const int tid = opq_tid(), lane = tid & 63, wave = __builtin_amdgcn_readfirstlane(tid >> 6), lr = lane & 15, g = lane >> 4;
    LAS bf16_t* QiL = (LAS bf16_t*)lds;
    LAS bf16_t* PL = (LAS bf16_t*)(lds + 33792);
    LAS float* red = (LAS float*)(lds + 43008);
    LAS float* rsL = (LAS float*)(lds + 45056);
    const bf16_t* PROJ = (const bf16_t*)(a->ws + WS_PROJ); bf16_t* OG = (bf16_t*)(a->ws + WS_OG);
    const float* hn = a->in[10] + (size_t)l * 512;
    for (int it = vcu; it < 1088; it += G) {
        int row0, h;
        if (it < 1024) { const int s = it >> 6, c = it & 63; h = s & 3; row0 = (s >> 2) * 4096 + c * 64; }
        else { const int s = it - 1024; h = s & 3; row0 = MP + (s >> 2) * 64; }
        const unsigned char* gp = a->ws + WS_GPRE + (size_t)it * GPRE_ITEM;
        const bf16_t* Qi = (const bf16_t*)(gp + GP_QI); const bf16_t* Pg = (const bf16_t*)(gp + GP_P); const bf16_t* VT = (const bf16_t*)(gp + GP_VT);
        const bf16_t* ST = (const bf16_t*)(a->ws + WS_UST) + (size_t)it * 131072;
        LDS_BARRIER();
#pragma unroll
        for (int j = 0; j < 4; ++j) { const int p = tid + 512 * j; *(LAS u32x4*)(QiL + (p >> 5) * 264 + (p & 31) * 8) = *(const u32x4*)(Qi + (size_t)p * 8); }
        *(LAS u32x4*)(PL + (tid >> 3) * 72 + (tid & 7) * 8) = *(const u32x4*)(Pg + (size_t)tid * 8);
        const bf16_t* vtp = VT + (size_t)(64 * wave + lr) * 64 + 8 * g; const bf16_t* stp = ST + (size_t)(64 * wave + lr) * 256 + 8 * g;
#define X3_A(st, mt) ((st) < 2 ? *(const bf16x8*)(vtp + (size_t)(mt) * 16 * 64 + 32 * (st)) : *(const bf16x8*)(stp + (size_t)(mt) * 16 * 256 + 32 * ((st) - 2)))
#define X3_B(st, nt) ((st) < 2 ? *(const LAS bf16x8*)(PL + (16 * (nt) + lr) * 72 + 32 * (st) + 8 * g) : *(const LAS bf16x8*)(QiL + (16 * (nt) + lr) * 264 + 32 * ((st) - 2) + 8 * g))
        bf16x8 A0[4][4], A1[3][4];
#pragma unroll
        for (int s_ = 0; s_ < 4; ++s_)
#pragma unroll
            for (int mt = 0; mt < 4; ++mt) A0[s_][mt] = X3_A(s_, mt);
#pragma unroll
        for (int s_ = 0; s_ < 3; ++s_)
#pragma unroll
            for (int mt = 0; mt < 4; ++mt) A1[s_][mt] = X3_A(4 + s_, mt);
        LDS_BARRIER();
        f32x4 o[4][4];
#pragma unroll
        for (int mt = 0; mt < 4; ++mt)
#pragma unroll
            for (int nt = 0; nt < 4; ++nt) o[mt][nt] = (f32x4){0.f, 0.f, 0.f, 0.f};
#pragma unroll
        for (int s_ = 0; s_ < 4; ++s_) { bf16x8 bf[4];
#pragma unroll
            for (int nt = 0; nt < 4; ++nt) bf[nt] = X3_B(s_, nt);
#pragma unroll
            for (int mt = 0; mt < 4; ++mt)
#pragma unroll
                for (int nt = 0; nt < 4; ++nt) o[mt][nt] = __builtin_amdgcn_mfma_f32_16x16x32_bf16(A0[s_][mt], bf[nt], o[mt][nt], 0, 0, 0); }
#pragma unroll
        for (int s_ = 0; s_ < 3; ++s_)
#pragma unroll
            for (int mt = 0; mt < 4; ++mt) A0[s_][mt] = X3_A(7 + s_, mt);
#pragma unroll
        for (int s_ = 0; s_ < 3; ++s_) { bf16x8 bf[4];
#pragma unroll
            for (int nt = 0; nt < 4; ++nt) bf[nt] = X3_B(4 + s_, nt);
#pragma unroll
            for (int mt = 0; mt < 4; ++mt)
#pragma unroll
                for (int nt = 0; nt < 4; ++nt) o[mt][nt] = __builtin_amdgcn_mfma_f32_16x16x32_bf16(A1[s_][mt], bf[nt], o[mt][nt], 0, 0, 0); }
#pragma unroll
        for (int s_ = 0; s_ < 3; ++s_) { bf16x8 bf[4];
#pragma unroll
            for (int nt = 0; nt < 4; ++nt) bf[nt] = X3_B(7 + s_, nt);
#pragma unroll
            for (int mt = 0; mt < 4; ++mt)
#pragma unroll
                for (int nt = 0; nt < 4; ++nt) o[mt][nt] = __builtin_amdgcn_mfma_f32_16x16x32_bf16(A0[s_][mt], bf[nt], o[mt][nt], 0, 0, 0); }
#undef X3_A
#undef X3_B
#pragma unroll
        for (int nt = 0; nt < 4; ++nt) { float s = 0.f;
#pragma unroll
            for (int mt = 0; mt < 4; ++mt)
#pragma unroll
                for (int i = 0; i < 4; ++i) s += o[mt][nt][i] * o[mt][nt][i];
            s += __shfl_xor(s, 16); s += __shfl_xor(s, 32);
            if (g == 0) red[wave * 64 + 16 * nt + lr] = s; }
        LDS_BARRIER();
        if (tid < 64) { float s = 0.f;
#pragma unroll
            for (int w = 0; w < 8; ++w) s += red[w * 64 + tid];
            rsL[tid] = rsqrtf(s * (1.f / 512.f) + EPS); }
        LDS_BARRIER();
#pragma unroll
        for (int nt = 0; nt < 4; ++nt) {
            const int t = 16 * nt + lr; const float rs = rsL[t];
#pragma unroll
            for (int mt = 0; mt < 4; ++mt) {
                const int vv = 64 * wave + 16 * mt + 4 * g;
                const u32x2 rv = *(const u32x2*)(PROJ + (size_t)(row0 + t) * NIN + 4096 + h * 512 + vv);
                const f32x4 gn = *(const f32x4*)(hn + vv);
                const float r0 = bf2f(rv.x & 0xffffu), r1 = bf2f(rv.x >> 16), r2 = bf2f(rv.y & 0xffffu), r3 = bf2f(rv.y >> 16);
                u32x2 w; w.x = pk2(o[mt][nt][0] * rs * gn[0] * silu_f(r0), o[mt][nt][1] * rs * gn[1] * silu_f(r1)); w.y = pk2(o[mt][nt][2] * rs * gn[2] * silu_f(r2), o[mt][nt][3] * rs * gn[3] * silu_f(r3));
                *(u32x2*)(OG + (size_t)(row0 + t) * DM + h * 512 + vv) = w;
            }
        }
    }
}

__device__ __forceinline__ void attn_phase(CArgs* a, LAS unsigned char* lds, int vcu, int G, int j  ) {
    const int tid = opq_tid(), lane = tid & 63, wave = __builtin_amdgcn_readfirstlane(tid >> 6), l32 = lane & 31, hf = lane >> 5;
    LAS bf16_t* KL = (LAS bf16_t*)lds;
    LAS unsigned* VTLw = (LAS unsigned*)(lds + 17408);
    LAS float* RB = (LAS float*)(lds + 35840);
    const bf16_t* Q = (const bf16_t*)(a->ws + WS_Q); bf16_t* OA = (bf16_t*)(a->ws + WS_OG);
    const bf16_t* KVP = (const bf16_t*)(a->ws + WS_KVP); const bf16_t* KVS = (const bf16_t*)(a->ws + WS_KVS);
    const int gq = wave >> 1, tq = 32 * (wave & 1) + l32;
    __syncthreads();
    for (int i = tid; i < 16 * 513; i += 512) RB[i] = a->in[15][(size_t)j * 16 * 513 + i] * 1.4426950408889634f;
    const bool deal = (G == 256);
    const int nmine = deal ? (vcu < 64 ? 5 : 4) : (1088 - vcu + G - 1) / G;
    for (int ii = 0; ii < nmine; ++ii) {
        int it;
        if (!deal) it = vcu + ii * G;
        else {
            int f = -1, sb = 0, sc = 0, sn = 0;
            if (vcu < 64) { if (ii < 3) f = vcu * 3 + ii; else { const int t = vcu & 3, bn = vcu >> 2; sb = bn >> 2; sn = bn & 3; sc = (ii == 3) ? t : 7 - t; } }
            else f = 192 + (vcu - 64) * 4 + ii;
            if (f < 0) it = sb * 256 + sc * 4 + sn;
            else if (f < 896) { const int b = f / 224, rem = f % 224; it = b * 256 + (8 + (rem >> 2)) * 4 + (rem & 3); }
            else it = 1024 + (f - 896);
        }
        int qrow0, n, ntile; const bf16_t* kvb;
        if (it < 1024) { const int b = it >> 8, c = (it >> 2) & 63; n = it & 3; qrow0 = b * 4096 + c * 64; ntile = (c < 8 ? c : 8) + 1; kvb = KVP + (size_t)(b * 4096 + (c - (ntile - 1)) * 64) * 1024; }
        else { const int s = it - 1024, b = s >> 2; n = s & 3; qrow0 = MP + b * 64; ntile = 9; kvb = KVS + (size_t)b * 576 * 1024; }
        const int hq = n * 4 + gq;
        __syncthreads();
        bf16x8 qf[8];
#pragma unroll
        for (int st = 0; st < 8; ++st) qf[st] = *(const bf16x8*)(Q + (size_t)(qrow0 + tq) * DM + hq * 128 + 16 * st + 8 * hf);
        float mrun = -1e30f, lrun = 0.f;
        f32x16 oacc[4];
#pragma unroll
        for (int dt = 0; dt < 4; ++dt)
#pragma unroll
            for (int i = 0; i < 16; ++i) oacc[dt][i] = 0.f;
        const int pcc = tid & 15, psp = tid >> 4;
        u32x4 kp0, kp1, vp0, vp1;
        { const bf16_t* kt = kvb + n * 128 + (size_t)(2 * psp) * 1024 + pcc * 8; kp0 = *(const u32x4*)kt; kp1 = *(const u32x4*)(kt + 1024); vp0 = *(const u32x4*)(kt + 512); vp1 = *(const u32x4*)(kt + 1536); }
        for (int tl = 0; tl < ntile; ++tl) {
            const int d = ntile - 1 - tl;
            LDS_BARRIER();
            *(LAS u32x4*)(KL + (2 * psp) * 136 + pcc * 8) = kp0; *(LAS u32x4*)(KL + (2 * psp + 1) * 136 + pcc * 8) = kp1;
#pragma unroll
            for (int e = 0; e < 4; ++e) { VTLw[(pcc * 8 + 2 * e) * 36 + (psp ^ (2 * pcc))] = (vp0[e] & 0xffffu) | (vp1[e] << 16); VTLw[(pcc * 8 + 2 * e + 1) * 36 + (psp ^ (2 * pcc))] = (vp0[e] >> 16) | (vp1[e] & 0xffff0000u); }
            if (tl + 1 < ntile) { const bf16_t* kt = kvb + (size_t)(tl + 1) * 64 * 1024 + n * 128 + (size_t)(2 * psp) * 1024 + pcc * 8; kp0 = *(const u32x4*)kt; kp1 = *(const u32x4*)(kt + 1024); vp0 = *(const u32x4*)(kt + 512); vp1 = *(const u32x4*)(kt + 1536); }
            LDS_BARRIER();
            f32x16 sacc[2];
#pragma unroll
            for (int ms = 0; ms < 2; ++ms) {
#pragma unroll
                for (int i = 0; i < 16; ++i) sacc[ms][i] = 0.f;
#pragma unroll
                for (int st = 0; st < 8; ++st) { const bf16x8 av = *(const LAS bf16x8*)(KL + (32 * ms + l32) * 136 + 16 * st + 8 * hf); sacc[ms] = __builtin_amdgcn_mfma_f32_32x32x16_bf16(av, qf[st], sacc[ms], 0, 0, 0); }
            }
            if (d >= 5) { const float bc = RB[hq * 513 + 512];
#pragma unroll
                for (int ms = 0; ms < 2; ++ms)
#pragma unroll
                    for (int i = 0; i < 16; ++i) sacc[ms][i] += bc; }
            else {
#pragma unroll
                for (int ms = 0; ms < 2; ++ms)
#pragma unroll
                    for (int i = 0; i < 16; ++i) { const int s = 32 * ms + 8 * (i >> 2) + 4 * hf + (i & 3); int rel = 64 * d + tq - s; rel = rel > 256 ? 256 : rel; sacc[ms][i] += RB[hq * 513 + rel + 256]; }
            }
            float mx = sacc[0][0];
#pragma unroll
            for (int ms = 0; ms < 2; ++ms)
#pragma unroll
                for (int i = 0; i < 16; ++i) mx = fmaxf(mx, sacc[ms][i]);
            mx = fmaxf(mx, __shfl_xor(mx, 32));
            const float mnew = fmaxf(mrun, mx), alpha = __builtin_amdgcn_exp2f(mrun - mnew);
            float ls = 0.f;
#pragma unroll
            for (int ms = 0; ms < 2; ++ms)
#pragma unroll
                for (int i = 0; i < 16; ++i) { const float p = __builtin_amdgcn_exp2f(sacc[ms][i] - mnew); sacc[ms][i] = p; ls += p; }
            ls += __shfl_xor(ls, 32);
            lrun = lrun * alpha + ls; mrun = mnew;
            if (__any(alpha != 1.f)) {
#pragma unroll
                for (int dt = 0; dt < 4; ++dt)
#pragma unroll
                    for (int i = 0; i < 16; ++i) oacc[dt][i] *= alpha;
            }
#pragma unroll
            for (int st2 = 0; st2 < 4; ++st2) {
                const int ms = st2 >> 1, i0 = 8 * (st2 & 1);
                u32x4 pw; pw.x = pk2_sw(sacc[ms][i0], sacc[ms][i0 + 1]); pw.y = pk2_sw(sacc[ms][i0 + 2], sacc[ms][i0 + 3]); pw.z = pk2_sw(sacc[ms][i0 + 4], sacc[ms][i0 + 5]); pw.w = pk2_sw(sacc[ms][i0 + 6], sacc[ms][i0 + 7]);
                const bf16x8 pb = __builtin_bit_cast(bf16x8, pw);
#pragma unroll
                for (int dt = 0; dt < 4; ++dt) {
                    const int dd = 32 * dt + l32, sw = 2 * ((dd >> 3) & 15);
                    const u32x2 lo = *(const LAS u32x2*)(VTLw + dd * 36 + ((8 * st2 + 2 * hf) ^ sw)), hi = *(const LAS u32x2*)(VTLw + dd * 36 + ((8 * st2 + 2 * hf + 4) ^ sw));
                    const bf16x8 av = __builtin_bit_cast(bf16x8, (u32x4){lo.x, lo.y, hi.x, hi.y});
                    oacc[dt] = __builtin_amdgcn_mfma_f32_32x32x16_bf16(av, pb, oacc[dt], 0, 0, 0);
                }
            }
        }
        const float inv = 1.f / lrun;
        bf16_t* orow = OA + (size_t)(qrow0 + tq) * DM + hq * 128;
#pragma unroll
        for (int dt = 0; dt < 4; ++dt)
#pragma unroll
            for (int i4 = 0; i4 < 4; ++i4) { u32x2 w; w.x = pk2(oacc[dt][4 * i4] * inv, oacc[dt][4 * i4 + 1] * inv); w.y = pk2(oacc[dt][4 * i4 + 2] * inv, oacc[dt][4 * i4 + 3] * inv);
                *(u32x2*)(orow + 32 * dt + 8 * i4 + 4 * hf) = w; }
    }
}

__global__ void __launch_bounds__(512) yoco_fwd(Args a_unused) {
    extern __shared__ __attribute__((aligned(16))) unsigned char lds_raw[];
    LAS unsigned char* lds = (LAS unsigned char*)lds_raw;
    cg::grid_group grid = cg::this_grid();
    const int G = gridDim.x, bx = blockIdx.x;
    const int vcu = (G % 8 == 0) ? (bx % 8) * (G / 8) + bx / 8 : bx;
    const int lo = get_args()->ph_lo, hi = get_args()->ph_hi;
    int ph = 0;
    if (threadIdx.x < 16) ((LAS unsigned*)(lds + LDS_BARST))[threadIdx.x] = 0u;
    __syncthreads();
    XcdBarrier bar = xcd_barrier_post((unsigned*)(get_args()->ws + WS_CTL), (volatile LAS unsigned*)(lds + LDS_BARST));
#define RUN (ph >= lo && ph < hi)
#ifndef R_SYNC
#define R_SYNC 1
#endif
#ifndef R_P0
#define R_P0 1
#endif
#ifndef R_PRE
#define R_PRE 1
#endif
#ifndef R_X3
#define R_X3 1
#endif
#ifndef R_X2
#define R_X2 1
#endif
#ifndef R_ATT
#define R_ATT 1
#endif
#ifndef R_CONV
#define R_CONV 1
#endif
#define GSYNC() do { if (lo < 0) grid.sync(); else xcd_barrier(bar); } while (0)
#define SEAM() do { ++ph; if (ph > lo && ph < hi) { for (int r_ = 0; r_ < R_SYNC; ++r_) GSYNC(); } } while (0)
#ifndef R_GEMM
#define R_GEMM 1
#endif
#define REP(n, call) do { for (int q_ = 0; q_ < (n); ++q_) { call; if (q_ + 1 < (n)) xcd_barrier(bar); } } while (0)

    if (RUN) REP(R_P0, p0_prologue(get_args(), lds, vcu, G));
    SEAM();
#pragma unroll 1
    for (int l = 0; l < 4; ++l) {
        if (RUN) {
            CArgs* a = get_args(); unsigned char* ws = a->ws; const bf16_t* H = (const bf16_t*)(ws + WS_XB);
            pg8::Gemm g; pg8::EpiGen E{};
            if (l < 2) { g = pg8::Gemm{H, (const bf16_t*)(ws + WS_WIN) + (size_t)l * NIN * 2048, M, NIN, 2048}; E.O = (bf16_t*)(ws + WS_PROJ); E.ldc = NIN; E.kvq = 0; }
            else if (l == 2) { g = pg8::Gemm{H, (const bf16_t*)(ws + WS_WKVQ), M, 3072, 2048}; E.O = (bf16_t*)(ws + WS_Q); E.ldc = DM; E.kvq = 1; }
            else { g = pg8::Gemm{H, (const bf16_t*)(ws + WS_WQ3), M, 2048, 2048}; E.O = (bf16_t*)(ws + WS_Q); E.ldc = DM; E.kvq = 0; }
            if (l == 2 && G != 256) kvs_cache_convert(a, vcu, G);
            E.rs = (const float*)(ws + WS_RS); E.KVP = (bf16_t*)(ws + WS_KVP); E.KVS = (bf16_t*)(ws + WS_KVS); E.okp = a->out + OUT_KP; E.ovp = a->out + OUT_VP; E.oks = a->out + OUT_KS; E.ovs = a->out + OUT_VS;
            pg8::StaticOrder S; S.init(g.M, g.N, G, bx);
            REP(R_GEMM, (pg8::gemm_phase<pg8::EpiGen, pg8::StaticOrder, true, true>(lds, g, S, E)));
            if (l < 2) convert_in_phase(a, lds, G, bx, l, 164, 0, 348); else if (l == 2) { if (G == 256 && bx >= 48) kvs_cache_convert(a, bx - 48, 208); convert_in_phase(a, lds, G, bx, l, 48, 0, 553); }
        }
        SEAM();
        if (l < 2) {
            if (RUN) REP(R_PRE, gla_pre(get_args(), lds, vcu, G, l));
            SEAM();
            if (RUN) REP(R_X2, gla_x2(get_args(), lds, vcu, G, l));
            SEAM();
            if (RUN) REP(R_X3, gla_x3(get_args(), lds, vcu, G, l));
            SEAM();
        } else {
            if (RUN) REP(R_ATT, attn_phase(get_args(), lds, vcu, G, l - 2));
            SEAM();
        }
        if (RUN) {
            unsigned char* ws = get_args()->ws; bf16_t* MF = (bf16_t*)(ws + WS_MF);
            const bf16_t* W = l < 2 ? (const bf16_t*)(ws + WS_GWO) + (size_t)l * 2048 * 2048 : (const bf16_t*)(ws + WS_AWO) + (size_t)(l - 2) * 2048 * 2048;
            pg8::Gemm g{(const bf16_t*)(ws + WS_OG), W, M, 2048, 2048}; pg8::EpiF32 E{MF, DM, (float*)(ws + WS_MFP), MP, (size_t)MS * DM, 0};
            pg8::TailSplitOrder S; S.init(MP / 256, MS / 256, 2048, 8, 2048, G, bx);
            REP(R_GEMM, (pg8::gemm_phase<pg8::EpiF32, pg8::TailSplitOrder, true, true>(lds, g, S, E)));
        }
        SEAM();
        if (RUN) norm_pass(get_args(), lds, vcu, G, get_args()->in[6] + (l * 4 + 1) * 2048, false, true, 8);
        SEAM();
        if (RUN) {
            unsigned char* ws = get_args()->ws; const bf16_t* H = (const bf16_t*)(ws + WS_XB);
            CArgs* a = get_args();
            pg8::Gemm g{H, (const bf16_t*)(ws + WS_WUP) + (size_t)l * NUP * 2048, M, NUP, 2048};
            pg8::EpiUp E{(bf16_t*)(ws + WS_HF), a->in[18] + (size_t)l * 3 * DFF, a->in[19] + (size_t)l * DFF, (float*)(ws + WS_GT), (float*)(ws + WS_GH), (float*)(ws + WS_VH), (const float*)(ws + WS_RS), 0, lds};
            pg8::StaticOrder S; S.init(g.M, g.N, G, bx);
            REP(R_GEMM, (pg8::gemm_phase<pg8::EpiUp, pg8::StaticOrder, true, true>(lds, g, S, E)));
            if (l < 2) convert_in_phase(a, lds, G, bx, l, 176, 348, 649); else convert_in_phase(a, lds, G, bx, l, 176, 553, 764);
        }
        SEAM();
        if (RUN) REP(R_CONV, conv_pass(get_args(), vcu, G, l));
        SEAM();
        if (RUN) {
            unsigned char* ws = get_args()->ws; bf16_t* MF = (bf16_t*)(ws + WS_MF);
            pg8::Gemm g{(const bf16_t*)(ws + WS_HF), (const bf16_t*)(ws + WS_WDN) + (size_t)l * 2048 * DFF, M, 2048, DFF}; pg8::EpiF32 E{MF, DM, (float*)(ws + WS_MFP), MP, (size_t)MS * DM, 0};
            pg8::TailSplitOrder S; S.init(MP / 256, MS / 256, 2048, 4, DFF, G, bx);
            REP(R_GEMM, (pg8::gemm_phase<pg8::EpiF32, pg8::TailSplitOrder, true, true>(lds, g, S, E)));
            if (l < 2) convert_in_phase(get_args(), lds, G, bx, l, 128, 649, 1024); else convert_in_phase(get_args(), lds, G, bx, l, 128, 764, 1024);
        }
        SEAM();
        if (RUN) norm_pass(get_args(), lds, vcu, G, get_args()->in[6] + (l * 4 + 3) * 2048, false, l < 3, 4);
        SEAM();
    }
#undef RUN
#undef SEAM
}

extern "C" void kernel_launch(void* const* d_in, const int* in_sizes, int n_in, void* d_out, int out_size, void* d_ws, size_t ws_size, hipStream_t stream) {
    static int grid = 0;
    if (grid == 0) {
        if (n_in != 21 || ws_size < WS_END6) { fprintf(stderr, "kernel_launch: unexpected n_in %d / ws_size %zu (need %zu)\n", n_in, ws_size, (size_t)WS_END6); grid = -1; return; }
        int dev = 0, cus = 0, per_cu = 0;
        hipGetDevice(&dev); hipDeviceGetAttribute(&cus, hipDeviceAttributeMultiprocessorCount, dev);
        hipFuncSetAttribute((const void*)yoco_fwd, hipFuncAttributeMaxDynamicSharedMemorySize, LDS_BYTES);
        hipOccupancyMaxActiveBlocksPerMultiprocessor(&per_cu, (const void*)yoco_fwd, 512, LDS_BYTES);
        if (per_cu < 1) { fprintf(stderr, "kernel_launch: occupancy query says %d blocks per CU\n", per_cu); per_cu = 1; }
        (void)hipGetLastError();
        grid = cus * per_cu;
    }
    if (grid < 0) return;
    if (hipMemsetAsync((char*)d_ws + WS_CTL, 0, CTL_BYTES, stream) != hipSuccess) { fprintf(stderr, "memset failed\n"); return; }
    Args a{};
    for (int i = 0; i < 21; ++i) a.in[i] = (const float*)d_in[i];
    a.out = (float*)d_out; a.ws = (unsigned char*)d_ws; a.ph_lo = 0; a.ph_hi = 1000;
    void* args[] = {&a};
    hipError_t e = hipLaunchCooperativeKernel((const void*)yoco_fwd, dim3(grid), dim3(512), args, LDS_BYTES, stream);
    if (e != hipSuccess) fprintf(stderr, "cooperative launch failed: %s (grid %d)\n", hipGetErrorString(e), grid);
}
```
